# Optimizing an MI355X kernel written in HIP

```python
import math
import jax, jax.numpy as jnp
from jax import lax
import numpy as np

D_MODEL = 1024
BATCH = 16
SEQ = 2048
DEPTH = 2

DIFF_HEADS = 4
DIFF_HEAD_DIM = 64
DIFF_V_DIM = 2 * DIFF_HEAD_DIM
DIFF_WIDTH = DIFF_HEADS * DIFF_V_DIM
WIN_HEADS = 8
WIN_KV_HEADS = 2
WIN_GROUP = WIN_HEADS // WIN_KV_HEADS
WIN_HEAD_DIM = 64
WIN_WIDTH = WIN_HEADS * WIN_HEAD_DIM
WINDOW = 128
BLOCK = 128
REL_BUCKETS = 32
REL_MAX_DIST = 128
TOTAL_HEADS = DIFF_HEADS + WIN_HEADS
C_DQ = DIFF_HEADS * 2 * DIFF_HEAD_DIM
C_DK = DIFF_HEADS * 2 * DIFF_HEAD_DIM
C_DV = DIFF_WIDTH
C_WQ = WIN_WIDTH
C_WK = WIN_KV_HEADS * WIN_HEAD_DIM
C_WV = WIN_KV_HEADS * WIN_HEAD_DIM
C_GATE = 2 * D_MODEL
IN_COLS = C_DQ + C_DK + C_DV + C_WQ + C_WK + C_WV + C_GATE
IN_SPLITS = (C_DQ, C_DQ + C_DK, C_DQ + C_DK + C_DV, C_DQ + C_DK + C_DV + C_WQ,
             C_DQ + C_DK + C_DV + C_WQ + C_WK, C_DQ + C_DK + C_DV + C_WQ + C_WK + C_WV)
N_GROUPS = 4
EXPERTS_PER_GROUP = 8
N_EXPERTS = N_GROUPS * EXPERTS_PER_GROUP
TOP_K = 2
EXPERT_HIDDEN = 512
MOE_BLOCK = 128
RMS_EPS = 1e-6
NEG_INF = -1e30

kernel_name = "hybrid_diffattn_wingqa_hiermoe_encoder"


def rms_norm(x, g):
    xf = x.astype(jnp.float32)
    y = xf * lax.rsqrt(jnp.mean(xf * xf, axis=-1, keepdims=True) + RMS_EPS)
    return (y * g.astype(jnp.float32)).astype(x.dtype)


def rel_bucket(rel):
    half = REL_BUCKETS // 2
    max_exact = half // 2
    n = jnp.abs(rel)
    nf = jnp.maximum(n, max_exact).astype(jnp.float32)
    large = max_exact + (jnp.log(nf / max_exact) / math.log(REL_MAX_DIST / max_exact)
                         * (half - max_exact)).astype(jnp.int32)
    large = jnp.minimum(large, half - 1)
    return jnp.where(rel > 0, half, 0) + jnp.where(n < max_exact, n, large)


def diff_attention(q, k, v, lam, rel_table, subln_g, lambda_init):
    B, S = q.shape[:2]
    nb = S // BLOCK
    scale = DIFF_HEAD_DIM ** -0.5
    k_pos = jnp.arange(S)
    qb = q.reshape(B, nb, BLOCK, DIFF_HEADS, 2, DIFF_HEAD_DIM).swapaxes(0, 1)

    def one_block(args):
        q_blk, start = args
        s = jnp.einsum('bqhcd,bkhcd->bhcqk', q_blk, k).astype(jnp.float32) * scale
        q_pos = start + jnp.arange(BLOCK)
        bias = rel_table[rel_bucket(k_pos[None, :] - q_pos[:, None])]
        s = s + bias.transpose(2, 0, 1)[None, :, None].astype(jnp.float32)
        p = jax.nn.softmax(s, axis=-1)
        a = p[:, :, 0] - lam * p[:, :, 1]
        return jnp.einsum('bhqk,bkhe->bqhe', a.astype(v.dtype), v)

    o = lax.map(one_block, (qb, jnp.arange(nb) * BLOCK))
    o = o.swapaxes(0, 1).reshape(B, S, DIFF_HEADS, DIFF_V_DIM)
    o = rms_norm(o, subln_g) * (1.0 - lambda_init)
    return o.reshape(B, S, DIFF_WIDTH)


def window_attention(q, k, v, rel_table, sink):
    B, S = q.shape[:2]
    nb = S // BLOCK
    scale = WIN_HEAD_DIM ** -0.5
    qb = q.reshape(B, nb, BLOCK, WIN_KV_HEADS, WIN_GROUP, WIN_HEAD_DIM).swapaxes(0, 1)
    pad = ((0, 0), (BLOCK, BLOCK), (0, 0), (0, 0))

    def band(t):
        tp = jnp.pad(t, pad)
        parts = [tp[:, o:o + S].reshape(B, nb, BLOCK, WIN_KV_HEADS, WIN_HEAD_DIM)
                 for o in (0, BLOCK, 2 * BLOCK)]
        return jnp.concatenate(parts, axis=2).swapaxes(0, 1)

    kb, vb = band(k), band(v)
    rel = jnp.arange(3 * BLOCK)[None, :] - BLOCK - jnp.arange(BLOCK)[:, None]
    bias = rel_table[rel_bucket(rel)].transpose(2, 0, 1)
    bias = bias.reshape(WIN_KV_HEADS, WIN_GROUP, BLOCK, 3 * BLOCK).astype(jnp.float32)
    k_pos = jnp.arange(nb)[:, None] * BLOCK - BLOCK + jnp.arange(3 * BLOCK)[None, :]
    valid = ((jnp.abs(rel) <= WINDOW)[None]
             & ((k_pos >= 0) & (k_pos < S))[:, None, :])
    sink_l = sink.reshape(WIN_KV_HEADS, WIN_GROUP)[None, :, :, None, None].astype(jnp.float32)

    def one_block(args):
        q_blk, k_blk, v_blk, ok = args
        s = jnp.einsum('bqhgd,bkhd->bhgqk', q_blk, k_blk).astype(jnp.float32) * scale + bias
        s = jnp.where(ok[None, None, None], s, NEG_INF)
        m = jnp.maximum(jnp.max(s, axis=-1, keepdims=True), sink_l)
        p = jnp.exp(s - m)
        p = p / (jnp.sum(p, axis=-1, keepdims=True) + jnp.exp(sink_l - m))
        return jnp.einsum('bhgqk,bkhd->bqhgd', p.astype(v_blk.dtype), v_blk)

    o = lax.map(one_block, (qb, kb, vb, valid))
    return o.swapaxes(0, 1).reshape(B, S, WIN_WIDTH)


def hier_moe(h, w_rg, b_rg, w_re, b_re, w_gate, w_up, w_down):
    B, S, D = h.shape
    N = B * S
    t = h.reshape(N, D)
    g_logits = (t @ w_rg).astype(jnp.float32) + b_rg.astype(jnp.float32)
    g_prob = jax.nn.softmax(g_logits, axis=-1)
    g_sel = jnp.argmax(g_logits, axis=-1).astype(jnp.int32)
    g_w = jnp.take_along_axis(g_prob, g_sel[:, None], axis=-1)
    e_logits = ((t @ w_re).astype(jnp.float32) + b_re.astype(jnp.float32))
    e_logits = e_logits.reshape(N, N_GROUPS, EXPERTS_PER_GROUP)
    e_logits = jnp.take_along_axis(e_logits, g_sel[:, None, None], axis=1)[:, 0]
    top_v, top_i = lax.top_k(e_logits, TOP_K)
    weights = jax.nn.softmax(top_v, axis=-1) * g_w
    expert = g_sel[:, None] * EXPERTS_PER_GROUP + top_i.astype(jnp.int32)

    A = N * TOP_K
    flat_e = expert.reshape(A)
    order = jnp.argsort(flat_e)
    sorted_e = flat_e[order]
    counts = jnp.bincount(flat_e, length=N_EXPERTS).astype(jnp.int32)
    padded = (counts + MOE_BLOCK - 1) // MOE_BLOCK * MOE_BLOCK
    pad_end = jnp.cumsum(padded)
    pad_start = pad_end - padded
    start = jnp.cumsum(counts) - counts
    dest_sorted = pad_start[sorted_e] + jnp.arange(A, dtype=jnp.int32) - start[sorted_e]
    dest = jnp.zeros((A,), jnp.int32).at[order].set(dest_sorted)
    n_blocks = -(-(A + N_EXPERTS * (MOE_BLOCK - 1)) // MOE_BLOCK)
    R = n_blocks * MOE_BLOCK
    row_token = jnp.full((R,), N, jnp.int32).at[dest].set(jnp.arange(A, dtype=jnp.int32) // TOP_K)
    t_pad = jnp.concatenate([t, jnp.zeros((1, D), t.dtype)], axis=0)
    xs = t_pad[row_token].reshape(n_blocks, MOE_BLOCK, D)
    block_e = jnp.minimum(jnp.searchsorted(pad_end, jnp.arange(n_blocks) * MOE_BLOCK, side='right'),
                          N_EXPERTS - 1).astype(jnp.int32)

    def expert_block(args):
        xb, e = args
        hid = jax.nn.silu(xb @ w_gate[e]) * (xb @ w_up[e])
        return hid @ w_down[e]

    ys = lax.map(expert_block, (xs, block_e)).reshape(R, D)
    y = ys[dest].reshape(N, TOP_K, D)
    out = jnp.einsum('nk,nkd->nd', weights.astype(y.dtype), y)
    return out.reshape(B, S, D)


def setup_inputs(seed: int = 0) -> dict:
    key = jax.random.key(seed)
    ks = jax.random.split(key, 20)

    def nrm(k, shape, s):
        return jax.random.normal(k, shape, jnp.float32) * s

    L, D, F, E = DEPTH, D_MODEL, EXPERT_HIDDEN, N_EXPERTS
    return {
        'x': nrm(ks[0], (BATCH, SEQ, D), 1.0),
        'w_in': nrm(ks[1], (L, D, IN_COLS), D ** -0.5),
        'diff_lambda': nrm(ks[2], (L, 4, DIFF_HEAD_DIM), 0.1),
        'diff_subln': 1.0 + nrm(ks[3], (L, DIFF_V_DIM), 0.02),
        'win_sink': nrm(ks[4], (L, WIN_HEADS), 0.5),
        'w_branch_diff': nrm(ks[5], (L, DIFF_WIDTH, D), DIFF_WIDTH ** -0.5),
        'w_branch_win': nrm(ks[6], (L, WIN_WIDTH, D), WIN_WIDTH ** -0.5),
        'w_out': nrm(ks[7], (L, D, D), D ** -0.5),
        'rel_bias': nrm(ks[8], (REL_BUCKETS, TOTAL_HEADS), 0.5),
        'norm_mix': 1.0 + nrm(ks[9], (L, D), 0.02),
        'norm_ffn': 1.0 + nrm(ks[10], (L, D), 0.02),
        'w_router_group': nrm(ks[11], (L, D, N_GROUPS), D ** -0.5),
        'b_router_group': nrm(ks[12], (L, N_GROUPS), 0.01),
        'w_router_expert': nrm(ks[13], (L, D, E), D ** -0.5),
        'b_router_expert': nrm(ks[14], (L, E), 0.01),
        'w_exp_gate': nrm(ks[15], (L, E, D, F), D ** -0.5),
        'w_exp_up': nrm(ks[16], (L, E, D, F), D ** -0.5),
        'w_exp_down': nrm(ks[17], (L, E, F, D), F ** -0.5),
        'norm_final': 1.0 + nrm(ks[18], (D,), 0.02),
    }


def reference(x, w_in, diff_lambda, diff_subln, win_sink, w_branch_diff, w_branch_win, w_out,
              rel_bias, norm_mix, norm_ffn, w_router_group, b_router_group, w_router_expert,
              b_router_expert, w_exp_gate, w_exp_up, w_exp_down, norm_final):
    B, S, _ = x.shape
    rel_diff = rel_bias[:, :DIFF_HEADS]
    rel_win = rel_bias[:, DIFF_HEADS:]
    for l in range(DEPTH):
        h = rms_norm(x, norm_mix[l])
        proj = h @ w_in[l]
        dq, dk, dv, wq, wk, wv, gates = jnp.split(proj, IN_SPLITS, axis=-1)

        lambda_init = 0.8 - 0.6 * math.exp(-0.3 * l)
        lam_p = diff_lambda[l].astype(jnp.float32)
        lam = (jnp.exp(jnp.sum(lam_p[0] * lam_p[1])) - jnp.exp(jnp.sum(lam_p[2] * lam_p[3]))
               + lambda_init)
        o_diff = diff_attention(dq.reshape(B, S, DIFF_HEADS, 2, DIFF_HEAD_DIM),
                                dk.reshape(B, S, DIFF_HEADS, 2, DIFF_HEAD_DIM),
                                dv.reshape(B, S, DIFF_HEADS, DIFF_V_DIM),
                                lam, rel_diff, diff_subln[l], lambda_init)
        o_win = window_attention(wq.reshape(B, S, WIN_HEADS, WIN_HEAD_DIM),
                                 wk.reshape(B, S, WIN_KV_HEADS, WIN_HEAD_DIM),
                                 wv.reshape(B, S, WIN_KV_HEADS, WIN_HEAD_DIM),
                                 rel_win, win_sink[l])

        gate_diff, gate_win = jnp.split(jax.nn.sigmoid(gates), 2, axis=-1)
        merged = gate_diff * (o_diff @ w_branch_diff[l]) + gate_win * (o_win @ w_branch_win[l])
        x = x + merged @ w_out[l]

        x = x + hier_moe(rms_norm(x, norm_ffn[l]), w_router_group[l], b_router_group[l],
                         w_router_expert[l], b_router_expert[l],
                         w_exp_gate[l], w_exp_up[l], w_exp_down[l])
    return rms_norm(x, norm_final)
```

```cpp
#include <hip/hip_runtime.h>
#include <cstdio>
#include <cstdint>

namespace pg8 {
#define PG8_LAS __attribute__((address_space(3)))
typedef unsigned short bf16_t;
typedef short bf16x8 __attribute__((ext_vector_type(8)));
typedef float f32x4 __attribute__((ext_vector_type(4)));
typedef unsigned u32x4 __attribute__((ext_vector_type(4)));
constexpr int BM = 256, BK = 64, HALF = 128, HTB = HALF * BK * 2  , STAGE_BYTES = 8 * HTB, NXCD = 8, WGM = 8;

__host__ __device__ __forceinline__ int lds_byte(int r, int c) { const int st = (r >> 4) * 2 + (c >> 5), rr = r & 15, cc = c & 31, ob = rr * 64 + cc * 2; return st * 1024 + (ob ^ (((ob >> 9) & 1) << 5)); }
__host__ __device__ __forceinline__ void stage_rc(int b, int& R, int& C) { const int st = b / 1024, sb = b % 1024, swz = sb ^ (((sb >> 9) & 1) << 5); R = (st >> 1) * 16 + swz / 64; C = (st & 1) * 32 + (swz % 64) / 2; }
__host__ __device__ __forceinline__ int perm32(int rho) { const int n = rho >> 4, i = rho & 15; return 8 * (i >> 2) + 4 * n + (i & 3); }

struct Unit { int pm, pn; };
struct Gemm { const bf16_t* A; const bf16_t* Bt; int M, N, K; };

struct StaticOrder {
    int nM, nN, nwg, G, c;
    __host__ __device__ void init(int M, int N, int G_, int c_) { nM = M / BM; nN = N / BM; nwg = nM * nN; G = G_; c = c_; }
    __host__ __device__ bool from_slot(long L, Unit& u) const {
        if (L >= nwg) return false;
        int wgid = (int)L; { const int q = nwg / NXCD, r = nwg % NXCD, xcd = wgid % NXCD, off = wgid / NXCD; wgid = (xcd < r ? xcd * (q + 1) : r * (q + 1) + (xcd - r) * q) + off; }
        const int nig = WGM * nN, gid = wgid / nig, fm = gid * WGM, gsz = (nM - fm) < WGM ? (nM - fm) : WGM;
        u.pm = fm + ((wgid % nig) % gsz); u.pn = (wgid % nig) / gsz; return true;
    }
    __host__ __device__ bool next(int i, Unit& u) const { return from_slot((long)i * G + c, u); }
    __device__ __forceinline__ void a_ready(const Unit&) const {}
    __device__ __forceinline__ void done(const Unit&) const {}
};
struct ColWindowOrder {
    StaticOrder b; int pn0;
    __host__ __device__ void init(int M, int ncols, int pn0_, int G_, int c_) { b.init(M, ncols, G_, c_); pn0 = pn0_; }
    __host__ __device__ bool next(int i, Unit& u) const { if (!b.next(i, u)) return false; u.pn += pn0; return true; }
    __device__ __forceinline__ void a_ready(const Unit&) const {}
    __device__ __forceinline__ void done(const Unit&) const {}
};
struct LateOrder {
    StaticOrder b; bool skew; int pn0;
    __host__ __device__ void init(int M, int N, int pn0_, int G_, int c_) { b.init(M, N, G_, c_); pn0 = pn0_; skew = (b.nwg == 4 * G_) && (G_ % 2 == 0); }
    __host__ __device__ bool slot(int i, Unit& u) const {
        if (!skew) return b.next(i, u);
        const int hg = b.G / 2;
        if (i < 3) return b.from_slot((long)i * b.G + b.c, u);
        if (b.c < hg || i > 4) return false;
        return b.from_slot((long)3 * b.G + (i - 3) * hg + (b.c - hg), u);
    }
    __host__ __device__ bool next(int i, Unit& u) const { if (!slot(i, u)) return false; u.pn += pn0; return true; }
    __device__ __forceinline__ void a_ready(const Unit&) const {}
    __device__ __forceinline__ void done(const Unit&) const {}
};

__device__ __forceinline__ unsigned cvt_pk_bf16(float lo, float hi) { unsigned r; asm volatile("v_cvt_pk_bf16_f32 %0, %1, %2" : "=v"(r) : "v"(lo), "v"(hi)); return r; }

#ifndef EPI_TWICE_MASK
#define EPI_TWICE_MASK 0
#endif
typedef float f32x2 __attribute__((ext_vector_type(2)));
#define PG8_GAS __attribute__((address_space(1)))
__device__ __forceinline__ float bf_lo(unsigned w) { return __uint_as_float(w << 16); }
__device__ __forceinline__ float bf_hi(unsigned w) { return __uint_as_float(w & 0xffff0000u); }
__device__ __forceinline__ float sigmoid_f(float x) { return __builtin_amdgcn_rcpf(1.0f + __builtin_amdgcn_exp2f(-1.4426950408889634f * x)); }
__device__ __forceinline__ u32x4 pack8(const f32x4 v0, const f32x4 v1) { u32x4 w; w.x = cvt_pk_bf16(v0[0], v0[1]); w.y = cvt_pk_bf16(v0[2], v0[3]); w.z = cvt_pk_bf16(v1[0], v1[1]); w.w = cvt_pk_bf16(v1[2], v1[3]); return w; }

struct EpiInProj {
    static constexpr bool PERM = true, AFTER_DRAIN = false, HAS_MID = false, PROBE2 = (EPI_TWICE_MASK & 2) != 0, FP8 = false;
    bf16_t* qkv; bf16_t* gates; const float* rs;
    __device__ __forceinline__ void operator()(const f32x4 (&acc)[2][2][4][2], const Unit& u, int wr, int wc, int fr, int fq) const {
        const int row0 = u.pm * BM + wr * 64 + fr; int colt = u.pn * BM;
        const bool isg = colt >= 2304; bf16_t* base = isg ? gates : qkv; const int ldc = isg ? 2048 : 2304; if (isg) colt -= 2304;
        const int col0 = colt + wc * 32 + 8 * fq;
#pragma unroll
        for (int ai = 0; ai < 2; ++ai)
#pragma unroll
            for (int m = 0; m < 4; ++m) { bf16_t* rowp = base + (size_t)(row0 + ai * HALF + m * 16) * ldc + col0; const float rr = rs[row0 + ai * HALF + m * 16];
#pragma unroll
                for (int bj = 0; bj < 2; ++bj) { f32x4 v0 = acc[ai][bj][m][0] * rr, v1 = acc[ai][bj][m][1] * rr;
                    if (isg) {
#pragma unroll
                        for (int i = 0; i < 4; ++i) { v0[i] = sigmoid_f(v0[i]); v1[i] = sigmoid_f(v1[i]); } }
                    *(u32x4*)(rowp + bj * HALF) = pack8(v0, v1); } }
    }
};
struct EpiInProj8 {
    static constexpr bool PERM = true, AFTER_DRAIN = false, HAS_MID = false, PROBE2 = false, FP8 = true;
    static constexpr int SCALE_X = 125, SCALE_W = 122;
    bf16_t* qkv; unsigned char* gates; const float* rs;
    __device__ __forceinline__ void operator()(const f32x4 (&acc)[2][2][4][2], const Unit& u, int wr, int wc, int fr, int fq) const {
        const int row0 = u.pm * BM + wr * 64 + fr; const int col0 = u.pn * BM - 2304 + wc * 32 + 8 * fq;
        typedef unsigned u32x2 __attribute__((ext_vector_type(2)));
#pragma unroll
        for (int ai = 0; ai < 2; ++ai)
#pragma unroll
            for (int m = 0; m < 4; ++m) { unsigned char* rowp = gates + (size_t)(row0 + ai * HALF + m * 16) * 2048 + col0; const float kk = rs[row0 + ai * HALF + m * 16] * -1.4426950408889634f;
#pragma unroll
                for (int bj = 0; bj < 2; ++bj) { const f32x4 a0 = acc[ai][bj][m][0], a1 = acc[ai][bj][m][1]; u32x2 o; o.x = 0u; o.y = 0u;
                    float e_[8];
#pragma unroll
                    for (int i = 0; i < 4; ++i) { e_[i] = a0[i] * kk; e_[4 + i] = a1[i] * kk; }
#pragma unroll
                    for (int i = 0; i < 8; ++i) e_[i] = __builtin_amdgcn_exp2f(e_[i]);
#pragma unroll
                    for (int i = 0; i < 8; ++i) e_[i] = __builtin_fmaf(e_[i], 1.0f / 255.0f, 1.0f / 255.0f);
#pragma unroll
                    for (int i = 0; i < 8; ++i) e_[i] = __builtin_amdgcn_rcpf(e_[i]);
                    o.x = __builtin_amdgcn_cvt_pk_u8_f32(e_[0], 0, o.x); o.y = __builtin_amdgcn_cvt_pk_u8_f32(e_[4], 0, o.y); o.x = __builtin_amdgcn_cvt_pk_u8_f32(e_[1], 1, o.x); o.y = __builtin_amdgcn_cvt_pk_u8_f32(e_[5], 1, o.y);
                    o.x = __builtin_amdgcn_cvt_pk_u8_f32(e_[2], 2, o.x); o.y = __builtin_amdgcn_cvt_pk_u8_f32(e_[6], 2, o.y); o.x = __builtin_amdgcn_cvt_pk_u8_f32(e_[3], 3, o.x); o.y = __builtin_amdgcn_cvt_pk_u8_f32(e_[7], 3, o.y);
                    *(u32x2*)(rowp + bj * HALF) = o; } }
    }
};
struct EpiMergeF {
    static constexpr bool PERM = true, AFTER_DRAIN = false, HAS_MID = true, PROBE2 = false, FP8 = false;
    const unsigned char* gates; bf16_t* out;
    typedef unsigned u32x2 __attribute__((ext_vector_type(2)));
    static __device__ __forceinline__ float ub(unsigned w, int i) { return (float)((w >> (8 * i)) & 0xffu); }
    __device__ __forceinline__ void mid(f32x4 (&acc)[2][2][4][2], const Unit& u, int wr, int wc, int fr, int fq) const {
        int fr_ = fr, fq_ = fq; asm volatile("" : "+v"(fr_), "+v"(fq_));
        const PG8_GAS unsigned char* gp = (const PG8_GAS unsigned char*)gates + (size_t)(u.pm * BM + wr * 64 + fr_) * 2048 + (u.pn * BM + wc * 32 + 8 * fq_);
#pragma unroll
        for (int ai = 0; ai < 2; ++ai) {
#pragma unroll
            for (int m = 0; m < 4; ++m) {
#pragma unroll
                for (int bj = 0; bj < 2; ++bj) {
                    const u32x2 gd = *(const PG8_GAS u32x2*)(gp + bj * HALF), gw = *(const PG8_GAS u32x2*)(gp + 1024 + bj * HALF);
                    f32x4& v0 = acc[ai][bj][m][0]; f32x4& v1 = acc[ai][bj][m][1];
#pragma unroll
                    for (int i = 0; i < 4; ++i) { v0[i] *= ub(gd.x, i) * __builtin_amdgcn_rcpf(fmaxf(ub(gw.x, i), 1.f)); v1[i] *= ub(gd.y, i) * __builtin_amdgcn_rcpf(fmaxf(ub(gw.y, i), 1.f)); } }
                gp += 16 * 2048; asm volatile("" : "+v"(gp)); }
            gp += 64 * 2048; asm volatile("" : "+v"(gp)); }
    }
    __device__ __forceinline__ void operator()(const f32x4 (&acc)[2][2][4][2], const Unit& u, int wr, int wc, int fr, int fq) const {
        const int row0 = u.pm * BM + wr * 64 + fr; const int col0 = u.pn * BM + wc * 32 + 8 * fq;
        const PG8_GAS unsigned char* gp = (const PG8_GAS unsigned char*)gates + (size_t)row0 * 2048 + 1024 + col0; PG8_GAS bf16_t* op = (PG8_GAS bf16_t*)out + (size_t)row0 * 1024 + col0;
#pragma unroll
        for (int ai = 0; ai < 2; ++ai) {
#pragma unroll
            for (int m = 0; m < 4; ++m) {
#pragma unroll
                for (int bj = 0; bj < 2; ++bj) {
                    const u32x2 g = *(const PG8_GAS u32x2*)(gp + bj * HALF);
                    f32x4 v0 = acc[ai][bj][m][0], v1 = acc[ai][bj][m][1];
#pragma unroll
                    for (int i = 0; i < 4; ++i) { v0[i] *= fmaxf(ub(g.x, i), 1.f) * (1.0f / 255.0f); v1[i] *= fmaxf(ub(g.y, i), 1.f) * (1.0f / 255.0f); }
                    *(PG8_GAS u32x4*)(op + bj * HALF) = pack8(v0, v1); }
                gp += 16 * 2048; op += 16 * 1024; asm volatile("" : "+v"(gp), "+v"(op)); }
            gp += 64 * 2048; op += 64 * 1024; asm volatile("" : "+v"(gp), "+v"(op)); }
    }
};
struct EpiResid {
    static constexpr bool PERM = true, AFTER_DRAIN = false, HAS_MID = false, PROBE2 = false, FP8 = false;
    const bf16_t* base; bf16_t* out;
    __device__ __forceinline__ void operator()(const f32x4 (&acc)[2][2][4][2], const Unit& u, int wr, int wc, int fr, int fq) const {
        const size_t off0 = (size_t)(u.pm * BM + wr * 64 + fr) * 1024 + (u.pn * BM + wc * 32 + 8 * fq);
        const PG8_GAS bf16_t* bp = (const PG8_GAS bf16_t*)base + off0; PG8_GAS bf16_t* op = (PG8_GAS bf16_t*)out + off0;
#pragma unroll
        for (int ai = 0; ai < 2; ++ai) {
#pragma unroll
            for (int m = 0; m < 4; ++m) {
#pragma unroll
                for (int bj = 0; bj < 2; ++bj) { const u32x4 b = *(const PG8_GAS u32x4*)(bp + bj * HALF);
                    f32x4 v0 = acc[ai][bj][m][0], v1 = acc[ai][bj][m][1];
                    v0[0] += bf_lo(b.x); v0[1] += bf_hi(b.x); v0[2] += bf_lo(b.y); v0[3] += bf_hi(b.y);
                    v1[0] += bf_lo(b.z); v1[1] += bf_hi(b.z); v1[2] += bf_lo(b.w); v1[3] += bf_hi(b.w);
                    *(PG8_GAS u32x4*)(op + bj * HALF) = pack8(v0, v1); }
                bp += 16 * 1024; op += 16 * 1024; asm volatile("" : "+v"(bp), "+v"(op)); }
            bp += 64 * 1024; op += 64 * 1024; asm volatile("" : "+v"(bp), "+v"(op)); }
    }
};
struct EpiSwiGlu {
    static constexpr bool PERM = true, AFTER_DRAIN = false, HAS_MID = false, PROBE2 = false, FP8 = false;
    bf16_t* hid;
    __device__ __forceinline__ void operator()(const f32x4 (&acc)[2][2][4][2], const Unit& u, int wr, int wc, int fr, int fq) const {
        const int row0 = u.pm * BM + wr * 64 + fr; const int col0 = (u.pn & 3) * 128 + wc * 32 + 8 * fq;
#pragma unroll
        for (int ai = 0; ai < 2; ++ai)
#pragma unroll
            for (int m = 0; m < 4; ++m) { f32x4 h0, h1;
#pragma unroll
                for (int i = 0; i < 4; ++i) { const float g0 = acc[ai][0][m][0][i], g1 = acc[ai][0][m][1][i];
                    h0[i] = g0 * sigmoid_f(g0) * acc[ai][1][m][0][i]; h1[i] = g1 * sigmoid_f(g1) * acc[ai][1][m][1][i]; }
                *(u32x4*)(hid + (size_t)(row0 + ai * HALF + m * 16) * 512 + col0) = pack8(h0, h1); }
    }
};
struct EpiDown {
    static constexpr bool PERM = true, AFTER_DRAIN = false, HAS_MID = false, PROBE2 = (EPI_TWICE_MASK & 1) != 0, FP8 = false;
    bf16_t* O;
    __device__ __forceinline__ void operator()(const f32x4 (&acc)[2][2][4][2], const Unit& u, int wr, int wc, int fr, int fq) const {
        const int row0 = u.pm * BM + wr * 64 + fr; const int col0 = (u.pn & 3) * BM + wc * 32 + 8 * fq;
#pragma unroll
        for (int ai = 0; ai < 2; ++ai)
#pragma unroll
            for (int m = 0; m < 4; ++m) { bf16_t* rowp = O + (size_t)(row0 + ai * HALF + m * 16) * 1024 + col0;
#pragma unroll
                for (int bj = 0; bj < 2; ++bj) *(u32x4*)(rowp + bj * HALF) = pack8(acc[ai][bj][m][0], acc[ai][bj][m][1]); }
    }
};
constexpr float X8_MUL = 4.f, HID8_MUL = 8.f, WGU8_MUL = 32.f, WD8_MUL = 16.f;
__device__ __forceinline__ unsigned pk4_fp8(float a, float b, float c, float d) {
    a = fminf(fmaxf(a, -448.f), 448.f); b = fminf(fmaxf(b, -448.f), 448.f); c = fminf(fmaxf(c, -448.f), 448.f); d = fminf(fmaxf(d, -448.f), 448.f);
    int w = 0; w = __builtin_amdgcn_cvt_pk_fp8_f32(a, b, w, false); w = __builtin_amdgcn_cvt_pk_fp8_f32(c, d, w, true); return (unsigned)w;
}
struct EpiSwiGlu8 {
    static constexpr bool PERM = true, AFTER_DRAIN = false, HAS_MID = false, PROBE2 = false, FP8 = true;
    static constexpr int SCALE_X = 125, SCALE_W = 122;
    unsigned char* hid;
    __device__ __forceinline__ void operator()(const f32x4 (&acc)[2][2][4][2], const Unit& u, int wr, int wc, int fr, int fq) const {
        const int row0 = u.pm * BM + wr * 64 + fr; const int col0 = (u.pn & 3) * 128 + wc * 32 + 8 * fq;
#pragma unroll
        for (int ai = 0; ai < 2; ++ai)
#pragma unroll
            for (int m = 0; m < 4; ++m) { f32x4 h0, h1;
#pragma unroll
                for (int i = 0; i < 4; ++i) { const float g0 = acc[ai][0][m][0][i], g1 = acc[ai][0][m][1][i];
                    h0[i] = HID8_MUL * g0 * sigmoid_f(g0) * acc[ai][1][m][0][i]; h1[i] = HID8_MUL * g1 * sigmoid_f(g1) * acc[ai][1][m][1][i]; }
                f32x2 w; unsigned w0 = pk4_fp8(h0[0], h0[1], h0[2], h0[3]), w1 = pk4_fp8(h1[0], h1[1], h1[2], h1[3]);
                typedef unsigned u32x2 __attribute__((ext_vector_type(2))); u32x2 o; o.x = w0; o.y = w1;
                *(u32x2*)(hid + (size_t)(row0 + ai * HALF + m * 16) * 512 + col0) = o; (void)w; }
    }
};
constexpr float YS8_MUL = 16.f;
struct EpiDown8 {
    static constexpr bool PERM = true, AFTER_DRAIN = false, HAS_MID = false, PROBE2 = false, FP8 = true;
    static constexpr int SCALE_X = 124, SCALE_W = 123;
    unsigned char* O;
    __device__ __forceinline__ void operator()(const f32x4 (&acc)[2][2][4][2], const Unit& u, int wr, int wc, int fr, int fq) const {
        const int row0 = u.pm * BM + wr * 64 + fr; const int col0 = (u.pn & 3) * BM + wc * 32 + 8 * fq;
        typedef unsigned u32x2 __attribute__((ext_vector_type(2)));
#pragma unroll
        for (int ai = 0; ai < 2; ++ai)
#pragma unroll
            for (int m = 0; m < 4; ++m) { unsigned char* rowp = O + (size_t)(row0 + ai * HALF + m * 16) * 1024 + col0;
#pragma unroll
                for (int bj = 0; bj < 2; ++bj) { const f32x4 v0 = acc[ai][bj][m][0] * YS8_MUL, v1 = acc[ai][bj][m][1] * YS8_MUL;
                    u32x2 o; o.x = pk4_fp8(v0[0], v0[1], v0[2], v0[3]); o.y = pk4_fp8(v1[0], v1[1], v1[2], v1[3]);
                    *(u32x2*)(rowp + bj * HALF) = o; } }
    }
};
constexpr float O8_MUL = 8.f, PT8_MUL = 16.f, MRG8_MUL = 8.f, WO8_MUL = 32.f;
struct EpiMergeF8 {
    static constexpr bool PERM = true, AFTER_DRAIN = false, HAS_MID = true, PROBE2 = false, FP8 = true;
    static constexpr int SCALE_X = 124, SCALE_W = 123;
    const unsigned char* gates; unsigned char* out;
    typedef unsigned u32x2 __attribute__((ext_vector_type(2)));
    static __device__ __forceinline__ float ub(unsigned w, int i) { return (float)((w >> (8 * i)) & 0xffu); }
    __device__ __forceinline__ void mid(f32x4 (&acc)[2][2][4][2], const Unit& u, int wr, int wc, int fr, int fq) const {
        int fr_ = fr, fq_ = fq; asm volatile("" : "+v"(fr_), "+v"(fq_));
        const PG8_GAS unsigned char* gp = (const PG8_GAS unsigned char*)gates + (size_t)(u.pm * BM + wr * 64 + fr_) * 2048 + (u.pn * BM + wc * 32 + 8 * fq_);
        u32x2 gd[2][4][2], gw[2][4][2];
#pragma unroll
        for (int ai = 0; ai < 2; ++ai)
#pragma unroll
            for (int m = 0; m < 4; ++m)
#pragma unroll
                for (int bj = 0; bj < 2; ++bj) { gd[ai][m][bj] = *(const PG8_GAS u32x2*)(gp + (size_t)(ai * 128 + m * 16) * 2048 + bj * HALF); gw[ai][m][bj] = *(const PG8_GAS u32x2*)(gp + (size_t)(ai * 128 + m * 16) * 2048 + 1024 + bj * HALF); }
        __builtin_amdgcn_sched_barrier(0);
#pragma unroll
        for (int ai = 0; ai < 2; ++ai) {
#pragma unroll
            for (int m = 0; m < 4; ++m)
#pragma unroll
                for (int bj = 0; bj < 2; ++bj) { f32x4& v0 = acc[ai][bj][m][0]; f32x4& v1 = acc[ai][bj][m][1];
#pragma unroll
                    for (int i = 0; i < 4; ++i) { v0[i] *= ub(gd[ai][m][bj].x, i) * __builtin_amdgcn_rcpf(fmaxf(ub(gw[ai][m][bj].x, i), 1.f)); v1[i] *= ub(gd[ai][m][bj].y, i) * __builtin_amdgcn_rcpf(fmaxf(ub(gw[ai][m][bj].y, i), 1.f)); } }
            __builtin_amdgcn_sched_barrier(0); }
    }
    __device__ __forceinline__ void operator()(const f32x4 (&acc)[2][2][4][2], const Unit& u, int wr, int wc, int fr, int fq) const {
        const int row0 = u.pm * BM + wr * 64 + fr; const int col0 = u.pn * BM + wc * 32 + 8 * fq;
        const PG8_GAS unsigned char* gp = (const PG8_GAS unsigned char*)gates + (size_t)row0 * 2048 + 1024 + col0; PG8_GAS unsigned char* op = (PG8_GAS unsigned char*)out + (size_t)row0 * 1024 + col0;
#pragma unroll
        for (int ai = 0; ai < 2; ++ai) {
            u32x2 g[4][2];
#pragma unroll
            for (int m = 0; m < 4; ++m)
#pragma unroll
                for (int bj = 0; bj < 2; ++bj) g[m][bj] = *(const PG8_GAS u32x2*)(gp + (size_t)m * 16 * 2048 + bj * HALF);
            asm volatile("" : "+v"(g[0][0]), "+v"(g[0][1]), "+v"(g[1][0]), "+v"(g[1][1]), "+v"(g[2][0]), "+v"(g[2][1]), "+v"(g[3][0]), "+v"(g[3][1]));
#pragma unroll
            for (int m = 0; m < 4; ++m)
#pragma unroll
                for (int bj = 0; bj < 2; ++bj) {
                    f32x4 v0 = acc[ai][bj][m][0], v1 = acc[ai][bj][m][1];
#pragma unroll
                    for (int i = 0; i < 4; ++i) { v0[i] *= fmaxf(ub(g[m][bj].x, i), 1.f) * (MRG8_MUL / 255.0f); v1[i] *= fmaxf(ub(g[m][bj].y, i), 1.f) * (MRG8_MUL / 255.0f); }
                    u32x2 o; o.x = pk4_fp8(v0[0], v0[1], v0[2], v0[3]); o.y = pk4_fp8(v1[0], v1[1], v1[2], v1[3]);
                    *(PG8_GAS u32x2*)(op + (size_t)m * 16 * 1024 + bj * HALF) = o; }
            gp += 128 * 2048; op += 128 * 1024; asm volatile("" : "+v"(gp), "+v"(op)); }
    }
};
struct EpiResid8 {
    static constexpr bool PERM = true, AFTER_DRAIN = false, HAS_MID = false, PROBE2 = false, FP8 = true;
    static constexpr int SCALE_X = 124, SCALE_W = 122;
    const bf16_t* base; bf16_t* out;
    __device__ __forceinline__ void operator()(const f32x4 (&acc)[2][2][4][2], const Unit& u, int wr, int wc, int fr, int fq) const {
        const size_t off0 = (size_t)(u.pm * BM + wr * 64 + fr) * 1024 + (u.pn * BM + wc * 32 + 8 * fq);
        const PG8_GAS bf16_t* bp = (const PG8_GAS bf16_t*)base + off0; PG8_GAS bf16_t* op = (PG8_GAS bf16_t*)out + off0;
#pragma unroll
        for (int ai = 0; ai < 2; ++ai) {
            u32x4 b[4][2];
#pragma unroll
            for (int m = 0; m < 4; ++m)
#pragma unroll
                for (int bj = 0; bj < 2; ++bj) b[m][bj] = *(const PG8_GAS u32x4*)(bp + (size_t)m * 16 * 1024 + bj * HALF);
            asm volatile("" : "+v"(b[0][0]), "+v"(b[0][1]), "+v"(b[1][0]), "+v"(b[1][1]), "+v"(b[2][0]), "+v"(b[2][1]), "+v"(b[3][0]), "+v"(b[3][1]));
#pragma unroll
            for (int m = 0; m < 4; ++m)
#pragma unroll
                for (int bj = 0; bj < 2; ++bj) { const u32x4 bb = b[m][bj];
                    f32x4 v0 = acc[ai][bj][m][0], v1 = acc[ai][bj][m][1];
                    v0[0] += bf_lo(bb.x); v0[1] += bf_hi(bb.x); v0[2] += bf_lo(bb.y); v0[3] += bf_hi(bb.y);
                    v1[0] += bf_lo(bb.z); v1[1] += bf_hi(bb.z); v1[2] += bf_lo(bb.w); v1[3] += bf_hi(bb.w);
                    *(PG8_GAS u32x4*)(op + (size_t)m * 16 * 1024 + bj * HALF) = pack8(v0, v1); }
            bp += 128 * 1024; op += 128 * 1024; asm volatile("" : "+v"(bp), "+v"(op)); }
    }
};
struct MoeOrder {
    int nunits, G, c; const PG8_LAS int* tile_e; const PG8_LAS int* rowtab;
    __device__ __forceinline__ int arow(int ui, int r) const { return rowtab[ui * 256 + r]; }
    static __device__ __forceinline__ int unit_of(int L, int nunits) { const int q = nunits / NXCD, r = nunits % NXCD, xcd = L % NXCD, off = L / NXCD; return (xcd < r ? xcd * (q + 1) : r * (q + 1) + (xcd - r) * q) + off; }
    __device__ __forceinline__ bool next(int i, Unit& u) const { const int L = i * G + c; if (L >= nunits) return false; const int w = unit_of(L, nunits); u.pm = w >> 2; u.pn = __builtin_amdgcn_readfirstlane(tile_e[w >> 2]) * 4 + (w & 3); return true; }
    __device__ __forceinline__ void a_ready(const Unit&) const {}
    __device__ __forceinline__ void done(const Unit&) const {}
};

typedef int pg8_v8i __attribute__((ext_vector_type(8)));
typedef int pg8_v4i __attribute__((ext_vector_type(4)));
template <bool F8> struct pg8_fragT { bf16x8 q[2]; };
template <> struct pg8_fragT<true> { pg8_v8i v; };
__device__ __forceinline__ void pg8_mfma_f8(f32x4& acc, const pg8_v8i a, const pg8_v8i b, int sa, int sb) {
    asm volatile("v_mfma_scale_f32_16x16x128_f8f6f4 %0, %1, %2, %0, %3, %4 op_sel_hi:[0,0,0]" : "+v"(acc) : "v"(a), "v"(b), "v"(sa), "v"(sb));
}
template <class Epi, class Sched, bool ALIGN_EPI = false, bool SP2 = false>
__device__ __forceinline__ void gemm_phase(PG8_LAS unsigned char* lds, const Gemm g, const Sched& S, const Epi& E) {
    int tid_ = threadIdx.x; asm volatile("" : "+v"(tid_));
    const int tid = tid_, wid = __builtin_amdgcn_readfirstlane(tid >> 6), lane = tid & 63, wr = wid >> 2, wc = wid & 3, fr = lane & 15, fq = lane >> 4;
    int K_ = g.K; asm volatile("" : "+s"(K_));
    const int K = K_, nt = K / BK;
    unsigned voffA[2], voffB[2];
#pragma unroll
    for (int i = 0; i < 2; ++i) { int R, C; stage_rc(tid * 16 + i * 8192, R, C); const int Rb = Epi::PERM ? ((R & ~31) + perm32(R & 31)) : R;
        voffA[i] = (unsigned)(R * K + C) * 2u; voffB[i] = (unsigned)(Rb * K + C) * 2u; }
    const size_t kstep = (size_t)(BK * 2);
    const size_t hstep = (size_t)HALF * K * 2;
    const size_t tstep = 2 * hstep;
    const unsigned ldsw = (unsigned)wid * 1024u;
    const int aoff = lds_byte(wr * 64 + fr, fq * 8), boff = lds_byte(wc * 32 + fr, fq * 8);
#define PG8_SA(b, h) (((b) * 2 + (h)) * HTB)
#define PG8_SB(b, h) ((4 + (b) * 2 + (h)) * HTB)
#define PG8_STAGE(bufoff, gbase, voff) do { _Pragma("unroll") for (int _i = 0; _i < 2; ++_i) \
        __builtin_amdgcn_global_load_lds((const unsigned*)((const char*)(gbase) + (voff)[_i]), (PG8_LAS unsigned*)(lds + (bufoff) + ldsw + _i * 8192), 16, 0, 0); } while (0)
#define PG8_LDA(dst, b, h) do { _Pragma("unroll") for (int m = 0; m < 4; ++m) { if constexpr (Epi::FP8) { const pg8_v4i lo_ = *(const PG8_LAS pg8_v4i*)(lds + PG8_SA(b, h) + aoff + m * 2048), hi_ = *(const PG8_LAS pg8_v4i*)(lds + PG8_SA(b, h) + aoff + m * 2048 + 1024); \
        dst[m].v = __builtin_shufflevector(lo_, hi_, 0, 1, 2, 3, 4, 5, 6, 7); } else { _Pragma("unroll") for (int k = 0; k < 2; ++k) dst[m].q[k] = *(const PG8_LAS bf16x8*)(lds + PG8_SA(b, h) + aoff + m * 2048 + k * 1024); } } } while (0)
#define PG8_LDB(dst, b, h) do { _Pragma("unroll") for (int n = 0; n < 2; ++n) { if constexpr (Epi::FP8) { const pg8_v4i lo_ = *(const PG8_LAS pg8_v4i*)(lds + PG8_SB(b, h) + boff + n * 2048), hi_ = *(const PG8_LAS pg8_v4i*)(lds + PG8_SB(b, h) + boff + n * 2048 + 1024); \
        dst[n].v = __builtin_shufflevector(lo_, hi_, 0, 1, 2, 3, 4, 5, 6, 7); } else { _Pragma("unroll") for (int k = 0; k < 2; ++k) dst[n].q[k] = *(const PG8_LAS bf16x8*)(lds + PG8_SB(b, h) + boff + n * 2048 + k * 1024); } } } while (0)
#define PG8_MMA(ai, bj, At, Bt) do { __builtin_amdgcn_s_setprio(1); \
        if constexpr (Epi::FP8) {   \
            _Pragma("unroll") for (int m = 0; m < 4; ++m) _Pragma("unroll") for (int n = 0; n < 2; ++n) \
                pg8_mfma_f8(acc[ai][bj][m][n], Bt[n].v, At[m].v, sclW, sclX); \
        } else { _Pragma("unroll") for (int m = 0; m < 4; ++m) _Pragma("unroll") for (int n = 0; n < 2; ++n) _Pragma("unroll") for (int k = 0; k < 2; ++k) \
            acc[ai][bj][m][n] = __builtin_amdgcn_mfma_f32_16x16x32_bf16(Bt[n].q[k], At[m].q[k], acc[ai][bj][m][n], 0, 0, 0); } \
        __builtin_amdgcn_s_setprio(0); } while (0)
#define PG8_WAIT_V(n) asm volatile("s_waitcnt vmcnt(" #n ")" ::: "memory")
#define PG8_WAIT_L(n) asm volatile("s_waitcnt lgkmcnt(" #n ")" ::: "memory")
#define PG8_BAR __builtin_amdgcn_s_barrier()
#define PG8_SCHED __builtin_amdgcn_sched_barrier(0)
    Unit cur, nxt; int ui = 0;
    if (!S.next(0, cur)) return;
    f32x4 acc[2][2][4][2];
#pragma unroll
    for (int a = 0; a < 2; ++a)
#pragma unroll
        for (int b = 0; b < 2; ++b)
#pragma unroll
            for (int m = 0; m < 4; ++m)
#pragma unroll
                for (int n = 0; n < 2; ++n) acc[a][b][m][n] = (f32x4){0.f, 0.f, 0.f, 0.f};
    pg8_fragT<Epi::FP8> At[4], B0[2], B1[2];
    int sclW = 0, sclX = 0; if constexpr (Epi::FP8) { sclW = Epi::SCALE_W; sclX = Epi::SCALE_X; asm volatile("" : "+v"(sclW), "+v"(sclX)); }
    const char* cA = (const char*)g.A + (size_t)cur.pm * tstep; const char* cB = (const char*)g.Bt + (size_t)cur.pn * tstep;
    S.a_ready(cur);
    if constexpr (SP2) {
        PG8_STAGE(PG8_SB(0, 0), cB, voffB); PG8_STAGE(PG8_SB(0, 1), cB + hstep, voffB); PG8_STAGE(PG8_SA(0, 0), cA, voffA); PG8_STAGE(PG8_SA(0, 1), cA + hstep, voffA);
        if (wr == 1) PG8_BAR;
        PG8_WAIT_V(2); PG8_BAR;
        PG8_STAGE(PG8_SB(1, 0), cB + kstep, voffB); PG8_STAGE(PG8_SA(1, 0), cA + kstep, voffA); PG8_STAGE(PG8_SB(1, 1), cB + hstep + kstep, voffB);
        PG8_WAIT_V(6); PG8_BAR;
    } else {
        PG8_STAGE(PG8_SB(0, 0), cB, voffB); PG8_STAGE(PG8_SA(0, 0), cA, voffA); PG8_STAGE(PG8_SB(0, 1), cB + hstep, voffB); PG8_STAGE(PG8_SA(0, 1), cA + hstep, voffA);
        if (wr == 1) PG8_BAR;
        PG8_WAIT_V(4); PG8_BAR;
        PG8_STAGE(PG8_SB(1, 0), cB + kstep, voffB); PG8_STAGE(PG8_SA(1, 0), cA + kstep, voffA); PG8_STAGE(PG8_SB(1, 1), cB + hstep + kstep, voffB);
        PG8_WAIT_V(6); PG8_BAR;
    }
    for (;;) {
        const bool has_next = S.next(ui + 1, nxt);
        const char* nA = has_next ? (const char*)g.A + (size_t)nxt.pm * tstep : cA; const char* nB = has_next ? (const char*)g.Bt + (size_t)nxt.pn * tstep : cB;
#pragma unroll 1
        for (int t = 0; t < nt; t += 2) {
            if constexpr (Epi::HAS_MID) { if (t == (nt >> 1)) { if constexpr (Epi::FP8) asm volatile("s_nop 7\n\ts_nop 7\n\ts_nop 7" ::: "memory"); E.mid(acc, cur, wr, wc, fr, fq); } }
            const bool last = (t == nt - 2);
            const char* a1 = cA + (size_t)(t + 1) * kstep;
            const char* a2 = last ? nA : cA + (size_t)(t + 2) * kstep; const char* b2 = last ? nB : cB + (size_t)(t + 2) * kstep;
            const char* a3 = a2 + kstep; const char* b3 = b2 + kstep;
            if (last && has_next) S.a_ready(nxt);
            if constexpr (SP2) {
            PG8_LDB(B0, 0, 0); PG8_LDB(B1, 0, 1); PG8_SCHED; PG8_LDA(At, 0, 0); PG8_STAGE(PG8_SA(1, 1), a1 + hstep, voffA);
            PG8_WAIT_V(8); PG8_WAIT_L(0); PG8_BAR; PG8_MMA(0, 0, At, B0); PG8_MMA(0, 1, At, B1); PG8_BAR; PG8_SCHED;
            PG8_LDA(At, 0, 1); PG8_STAGE(PG8_SB(0, 0), b2, voffB); PG8_STAGE(PG8_SB(0, 1), b2 + hstep, voffB); PG8_STAGE(PG8_SA(0, 0), a2, voffA);
            PG8_WAIT_V(8); PG8_WAIT_L(0); PG8_BAR; PG8_MMA(1, 0, At, B0); PG8_MMA(1, 1, At, B1); PG8_BAR; PG8_SCHED;
            PG8_LDB(B0, 1, 0); PG8_LDB(B1, 1, 1); PG8_SCHED; PG8_LDA(At, 1, 0); PG8_STAGE(PG8_SA(0, 1), a2 + hstep, voffA);
            PG8_WAIT_V(8); PG8_WAIT_L(0); PG8_BAR; PG8_MMA(0, 0, At, B0); PG8_MMA(0, 1, At, B1); PG8_BAR; PG8_SCHED;
            PG8_LDA(At, 1, 1); PG8_STAGE(PG8_SB(1, 0), b3, voffB); PG8_STAGE(PG8_SB(1, 1), b3 + hstep, voffB); PG8_STAGE(PG8_SA(1, 0), a3, voffA);
            PG8_WAIT_V(8); PG8_WAIT_L(0); PG8_BAR; PG8_MMA(1, 0, At, B0); PG8_MMA(1, 1, At, B1); PG8_BAR; PG8_SCHED;
            } else {
            PG8_LDB(B0, 0, 0); PG8_SCHED; PG8_LDA(At, 0, 0); PG8_STAGE(PG8_SA(1, 1), a1 + hstep, voffA);
            PG8_WAIT_L(8); PG8_BAR; PG8_WAIT_L(0); PG8_MMA(0, 0, At, B0); PG8_BAR; PG8_SCHED;
            PG8_LDB(B1, 0, 1); PG8_STAGE(PG8_SB(0, 0), b2, voffB);
            PG8_BAR; PG8_WAIT_L(0); PG8_MMA(0, 1, At, B1); PG8_BAR;
            PG8_LDA(At, 0, 1); PG8_STAGE(PG8_SA(0, 0), a2, voffA);
            PG8_BAR; PG8_WAIT_L(0); PG8_MMA(1, 0, At, B0); PG8_BAR; PG8_SCHED;
            PG8_STAGE(PG8_SB(0, 1), b2 + hstep, voffB);
            PG8_WAIT_V(6); PG8_BAR; PG8_MMA(1, 1, At, B1); PG8_BAR;
            PG8_LDB(B0, 1, 0); PG8_SCHED; PG8_LDA(At, 1, 0); PG8_STAGE(PG8_SA(0, 1), a2 + hstep, voffA);
            PG8_WAIT_L(8); PG8_BAR; PG8_WAIT_L(0); PG8_MMA(0, 0, At, B0); PG8_BAR; PG8_SCHED;
            PG8_LDB(B1, 1, 1); PG8_STAGE(PG8_SB(1, 0), b3, voffB);
            PG8_BAR; PG8_WAIT_L(0); PG8_MMA(0, 1, At, B1); PG8_BAR;
            PG8_LDA(At, 1, 1); PG8_STAGE(PG8_SA(1, 0), a3, voffA);
            PG8_BAR; PG8_WAIT_L(0); PG8_MMA(1, 0, At, B0); PG8_BAR; PG8_SCHED;
            PG8_STAGE(PG8_SB(1, 1), b3 + hstep, voffB);
            PG8_WAIT_V(6); PG8_BAR; PG8_MMA(1, 1, At, B1); PG8_BAR;
            }
        }
        if constexpr (ALIGN_EPI) { if (wr == 0) PG8_BAR; }
        if constexpr (Epi::FP8) asm volatile("s_nop 7\n\ts_nop 7\n\ts_nop 7" ::: "memory");
        if constexpr (!Epi::AFTER_DRAIN) { E(acc, cur, wr, wc, fr, fq);
#ifdef EPI_TWICE
            if constexpr (Epi::PROBE2) { asm volatile("" ::: "memory"); E(acc, cur, wr, wc, fr, fq); }
#endif
            S.done(cur); }
        if (!has_next) break;
#pragma unroll
        for (int a = 0; a < 2; ++a)
#pragma unroll
            for (int b = 0; b < 2; ++b)
#pragma unroll
                for (int m = 0; m < 4; ++m)
#pragma unroll
                    for (int n = 0; n < 2; ++n) acc[a][b][m][n] = (f32x4){0.f, 0.f, 0.f, 0.f};
        cur = nxt; cA = nA; cB = nB; ++ui;
        if constexpr (ALIGN_EPI) { if (wr == 1) PG8_BAR; }
    }
    PG8_WAIT_V(0);
    if constexpr (!ALIGN_EPI) { if (wr == 0) PG8_BAR; }
    PG8_BAR;
    if constexpr (Epi::AFTER_DRAIN) { E.fused(acc, cur, wr, wc, fr, fq, lds, wid, lane); S.done(cur); }
#undef PG8_SA
#undef PG8_SB
#undef PG8_STAGE
#undef PG8_LDA
#undef PG8_LDB
#undef PG8_MMA
#undef PG8_WAIT_V
#undef PG8_WAIT_L
#undef PG8_BAR
#undef PG8_SCHED
}
template <class Epi, class Sched, bool ALIGN_EPI = false, bool SP2 = true>
__device__ __forceinline__ void gemm_phase_gather(PG8_LAS unsigned char* lds, const Gemm g, const Sched& S, const Epi& E) {
    int tid_ = threadIdx.x; asm volatile("" : "+v"(tid_));
    const int tid = tid_, wid = __builtin_amdgcn_readfirstlane(tid >> 6), lane = tid & 63, wr = wid >> 2, wc = wid & 3, fr = lane & 15, fq = lane >> 4;
    int K_ = g.K; asm volatile("" : "+s"(K_));
    const int K = K_, nt = K / BK;
    unsigned voffA[2], voffB[2];
    int Rr[2], Cc[2];
#pragma unroll
    for (int i = 0; i < 2; ++i) { int R, C; stage_rc(tid * 16 + i * 8192, R, C); const int Rb = Epi::PERM ? ((R & ~31) + perm32(R & 31)) : R; Rr[i] = R; Cc[i] = C;
        voffA[i] = (unsigned)(R * K + C) * 2u; voffB[i] = (unsigned)(Rb * K + C) * 2u; }
    static_assert(SP2, "the gather variant keeps only the SP2 loop");
    unsigned vA0[2], vA1[2], nA0[2], nA1[2];
#define PG8_GOFF(d0, d1, UI) do { _Pragma("unroll") for (int _i = 0; _i < 2; ++_i) { d0[_i] = (unsigned)(S.arow((UI), Rr[_i]) * K + Cc[_i]) * 2u; d1[_i] = (unsigned)(S.arow((UI), HALF + Rr[_i]) * K + Cc[_i]) * 2u; } } while (0)
    const size_t kstep = (size_t)(BK * 2);
    const size_t hstep = (size_t)HALF * K * 2;
    const size_t tstep = 2 * hstep;
    const unsigned ldsw = (unsigned)wid * 1024u;
    const int aoff = lds_byte(wr * 64 + fr, fq * 8), boff = lds_byte(wc * 32 + fr, fq * 8);
#define PG8_SA(b, h) (((b) * 2 + (h)) * HTB)
#define PG8_SB(b, h) ((4 + (b) * 2 + (h)) * HTB)
#define PG8_STAGE(bufoff, gbase, voff) do { _Pragma("unroll") for (int _i = 0; _i < 2; ++_i) \
        __builtin_amdgcn_global_load_lds((const unsigned*)((const char*)(gbase) + (voff)[_i]), (PG8_LAS unsigned*)(lds + (bufoff) + ldsw + _i * 8192), 16, 0, 0); } while (0)
#define PG8_LDA(dst, b, h) do { _Pragma("unroll") for (int m = 0; m < 4; ++m) { if constexpr (Epi::FP8) { const pg8_v4i lo_ = *(const PG8_LAS pg8_v4i*)(lds + PG8_SA(b, h) + aoff + m * 2048), hi_ = *(const PG8_LAS pg8_v4i*)(lds + PG8_SA(b, h) + aoff + m * 2048 + 1024); \
        dst[m].v = __builtin_shufflevector(lo_, hi_, 0, 1, 2, 3, 4, 5, 6, 7); } else { _Pragma("unroll") for (int k = 0; k < 2; ++k) dst[m].q[k] = *(const PG8_LAS bf16x8*)(lds + PG8_SA(b, h) + aoff + m * 2048 + k * 1024); } } } while (0)
#define PG8_LDB(dst, b, h) do { _Pragma("unroll") for (int n = 0; n < 2; ++n) { if constexpr (Epi::FP8) { const pg8_v4i lo_ = *(const PG8_LAS pg8_v4i*)(lds + PG8_SB(b, h) + boff + n * 2048), hi_ = *(const PG8_LAS pg8_v4i*)(lds + PG8_SB(b, h) + boff + n * 2048 + 1024); \
        dst[n].v = __builtin_shufflevector(lo_, hi_, 0, 1, 2, 3, 4, 5, 6, 7); } else { _Pragma("unroll") for (int k = 0; k < 2; ++k) dst[n].q[k] = *(const PG8_LAS bf16x8*)(lds + PG8_SB(b, h) + boff + n * 2048 + k * 1024); } } } while (0)
#define PG8_MMA(ai, bj, At, Bt) do { __builtin_amdgcn_s_setprio(1); \
        if constexpr (Epi::FP8) {   \
            _Pragma("unroll") for (int m = 0; m < 4; ++m) _Pragma("unroll") for (int n = 0; n < 2; ++n) \
                pg8_mfma_f8(acc[ai][bj][m][n], Bt[n].v, At[m].v, sclW, sclX); \
        } else { _Pragma("unroll") for (int m = 0; m < 4; ++m) _Pragma("unroll") for (int n = 0; n < 2; ++n) _Pragma("unroll") for (int k = 0; k < 2; ++k) \
            acc[ai][bj][m][n] = __builtin_amdgcn_mfma_f32_16x16x32_bf16(Bt[n].q[k], At[m].q[k], acc[ai][bj][m][n], 0, 0, 0); } \
        __builtin_amdgcn_s_setprio(0); } while (0)
#define PG8_WAIT_V(n) asm volatile("s_waitcnt vmcnt(" #n ")" ::: "memory")
#define PG8_WAIT_L(n) asm volatile("s_waitcnt lgkmcnt(" #n ")" ::: "memory")
#define PG8_BAR __builtin_amdgcn_s_barrier()
#define PG8_SCHED __builtin_amdgcn_sched_barrier(0)
    Unit cur, nxt; int ui = 0;
    if (!S.next(0, cur)) return;
    f32x4 acc[2][2][4][2];
#pragma unroll
    for (int a = 0; a < 2; ++a)
#pragma unroll
        for (int b = 0; b < 2; ++b)
#pragma unroll
            for (int m = 0; m < 4; ++m)
#pragma unroll
                for (int n = 0; n < 2; ++n) acc[a][b][m][n] = (f32x4){0.f, 0.f, 0.f, 0.f};
    pg8_fragT<Epi::FP8> At[4], B0[2], B1[2];
    int sclW = 0, sclX = 0; if constexpr (Epi::FP8) { sclW = Epi::SCALE_W; sclX = Epi::SCALE_X; asm volatile("" : "+v"(sclW), "+v"(sclX)); }
    const char* cA = (const char*)g.A; const char* cB = (const char*)g.Bt + (size_t)cur.pn * tstep;
    PG8_GOFF(vA0, vA1, 0);
    S.a_ready(cur);
    if constexpr (SP2) {
        PG8_STAGE(PG8_SB(0, 0), cB, voffB); PG8_STAGE(PG8_SB(0, 1), cB + hstep, voffB); PG8_STAGE(PG8_SA(0, 0), cA, vA0); PG8_STAGE(PG8_SA(0, 1), cA, vA1);
        if (wr == 1) PG8_BAR;
        PG8_WAIT_V(2); PG8_BAR;
        PG8_STAGE(PG8_SB(1, 0), cB + kstep, voffB); PG8_STAGE(PG8_SA(1, 0), cA + kstep, vA0); PG8_STAGE(PG8_SB(1, 1), cB + hstep + kstep, voffB);
        PG8_WAIT_V(6); PG8_BAR;
    } else {
        PG8_STAGE(PG8_SB(0, 0), cB, voffB); PG8_STAGE(PG8_SA(0, 0), cA, voffA); PG8_STAGE(PG8_SB(0, 1), cB + hstep, voffB); PG8_STAGE(PG8_SA(0, 1), cA + hstep, voffA);
        if (wr == 1) PG8_BAR;
        PG8_WAIT_V(4); PG8_BAR;
        PG8_STAGE(PG8_SB(1, 0), cB + kstep, voffB); PG8_STAGE(PG8_SA(1, 0), cA + kstep, voffA); PG8_STAGE(PG8_SB(1, 1), cB + hstep + kstep, voffB);
        PG8_WAIT_V(6); PG8_BAR;
    }
    for (;;) {
        const bool has_next = S.next(ui + 1, nxt);
        const char* nA = cA; const char* nB = has_next ? (const char*)g.Bt + (size_t)nxt.pn * tstep : cB;
        if (has_next) PG8_GOFF(nA0, nA1, ui + 1); else { nA0[0] = vA0[0]; nA0[1] = vA0[1]; nA1[0] = vA1[0]; nA1[1] = vA1[1]; }
#pragma unroll 1
        for (int t = 0; t < nt; t += 2) {
            if constexpr (Epi::HAS_MID) { if (t == (nt >> 1)) { if constexpr (Epi::FP8) asm volatile("s_nop 7\n\ts_nop 7\n\ts_nop 7" ::: "memory"); E.mid(acc, cur, wr, wc, fr, fq); } }
            const bool last = (t == nt - 2);
            const char* a1 = cA + (size_t)(t + 1) * kstep;
            const char* a2 = last ? nA : cA + (size_t)(t + 2) * kstep; const char* b2 = last ? nB : cB + (size_t)(t + 2) * kstep;
            const char* a3 = a2 + kstep; const char* b3 = b2 + kstep;
            if (last && has_next) S.a_ready(nxt);
            const unsigned wA0[2] = {last ? nA0[0] : vA0[0], last ? nA0[1] : vA0[1]}, wA1[2] = {last ? nA1[0] : vA1[0], last ? nA1[1] : vA1[1]};
            if constexpr (SP2) {
            PG8_LDB(B0, 0, 0); PG8_LDB(B1, 0, 1); PG8_SCHED; PG8_LDA(At, 0, 0); PG8_STAGE(PG8_SA(1, 1), a1, vA1);
            PG8_WAIT_V(8); PG8_WAIT_L(0); PG8_BAR; PG8_MMA(0, 0, At, B0); PG8_MMA(0, 1, At, B1); PG8_BAR; PG8_SCHED;
            PG8_LDA(At, 0, 1); PG8_STAGE(PG8_SB(0, 0), b2, voffB); PG8_STAGE(PG8_SB(0, 1), b2 + hstep, voffB); PG8_STAGE(PG8_SA(0, 0), a2, wA0);
            PG8_WAIT_V(8); PG8_WAIT_L(0); PG8_BAR; PG8_MMA(1, 0, At, B0); PG8_MMA(1, 1, At, B1); PG8_BAR; PG8_SCHED;
            PG8_LDB(B0, 1, 0); PG8_LDB(B1, 1, 1); PG8_SCHED; PG8_LDA(At, 1, 0); PG8_STAGE(PG8_SA(0, 1), a2, wA1);
            PG8_WAIT_V(8); PG8_WAIT_L(0); PG8_BAR; PG8_MMA(0, 0, At, B0); PG8_MMA(0, 1, At, B1); PG8_BAR; PG8_SCHED;
            PG8_LDA(At, 1, 1); PG8_STAGE(PG8_SB(1, 0), b3, voffB); PG8_STAGE(PG8_SB(1, 1), b3 + hstep, voffB); PG8_STAGE(PG8_SA(1, 0), a3, wA0);
            PG8_WAIT_V(8); PG8_WAIT_L(0); PG8_BAR; PG8_MMA(1, 0, At, B0); PG8_MMA(1, 1, At, B1); PG8_BAR; PG8_SCHED;
            } else {
            PG8_LDB(B0, 0, 0); PG8_SCHED; PG8_LDA(At, 0, 0); PG8_STAGE(PG8_SA(1, 1), a1 + hstep, voffA);
            PG8_WAIT_L(8); PG8_BAR; PG8_WAIT_L(0); PG8_MMA(0, 0, At, B0); PG8_BAR; PG8_SCHED;
            PG8_LDB(B1, 0, 1); PG8_STAGE(PG8_SB(0, 0), b2, voffB);
            PG8_BAR; PG8_WAIT_L(0); PG8_MMA(0, 1, At, B1); PG8_BAR;
            PG8_LDA(At, 0, 1); PG8_STAGE(PG8_SA(0, 0), a2, voffA);
            PG8_BAR; PG8_WAIT_L(0); PG8_MMA(1, 0, At, B0); PG8_BAR; PG8_SCHED;
            PG8_STAGE(PG8_SB(0, 1), b2 + hstep, voffB);
            PG8_WAIT_V(6); PG8_BAR; PG8_MMA(1, 1, At, B1); PG8_BAR;
            PG8_LDB(B0, 1, 0); PG8_SCHED; PG8_LDA(At, 1, 0); PG8_STAGE(PG8_SA(0, 1), a2 + hstep, voffA);
            PG8_WAIT_L(8); PG8_BAR; PG8_WAIT_L(0); PG8_MMA(0, 0, At, B0); PG8_BAR; PG8_SCHED;
            PG8_LDB(B1, 1, 1); PG8_STAGE(PG8_SB(1, 0), b3, voffB);
            PG8_BAR; PG8_WAIT_L(0); PG8_MMA(0, 1, At, B1); PG8_BAR;
            PG8_LDA(At, 1, 1); PG8_STAGE(PG8_SA(1, 0), a3, voffA);
            PG8_BAR; PG8_WAIT_L(0); PG8_MMA(1, 0, At, B0); PG8_BAR; PG8_SCHED;
            PG8_STAGE(PG8_SB(1, 1), b3 + hstep, voffB);
            PG8_WAIT_V(6); PG8_BAR; PG8_MMA(1, 1, At, B1); PG8_BAR;
            }
        }
        if constexpr (ALIGN_EPI) { if (wr == 0) PG8_BAR; }
        if constexpr (Epi::FP8) asm volatile("s_nop 7\n\ts_nop 7\n\ts_nop 7" ::: "memory");
        if constexpr (!Epi::AFTER_DRAIN) { E(acc, cur, wr, wc, fr, fq);
#ifdef EPI_TWICE
            if constexpr (Epi::PROBE2) { asm volatile("" ::: "memory"); E(acc, cur, wr, wc, fr, fq); }
#endif
            S.done(cur); }
        if (!has_next) break;
#pragma unroll
        for (int a = 0; a < 2; ++a)
#pragma unroll
            for (int b = 0; b < 2; ++b)
#pragma unroll
                for (int m = 0; m < 4; ++m)
#pragma unroll
                    for (int n = 0; n < 2; ++n) acc[a][b][m][n] = (f32x4){0.f, 0.f, 0.f, 0.f};
        cur = nxt; cA = nA; cB = nB; ++ui; vA0[0] = nA0[0]; vA0[1] = nA0[1]; vA1[0] = nA1[0]; vA1[1] = nA1[1];
        if constexpr (ALIGN_EPI) { if (wr == 1) PG8_BAR; }
    }
    PG8_WAIT_V(0);
    if constexpr (!ALIGN_EPI) { if (wr == 0) PG8_BAR; }
    PG8_BAR;
    if constexpr (Epi::AFTER_DRAIN) { E.fused(acc, cur, wr, wc, fr, fq, lds, wid, lane); S.done(cur); }
#undef PG8_SA
#undef PG8_SB
#undef PG8_STAGE
#undef PG8_LDA
#undef PG8_LDB
#undef PG8_MMA
#undef PG8_WAIT_V
#undef PG8_WAIT_L
#undef PG8_BAR
#undef PG8_SCHED
#undef PG8_GOFF
}
}

namespace att {
using bf16 = unsigned short;
using bf16x8 = __attribute__((ext_vector_type(8))) short;
using s16x4 = __attribute__((ext_vector_type(4))) short;
using f32x16 = __attribute__((ext_vector_type(16))) float;
using f32x4 = __attribute__((ext_vector_type(4))) float;
using u32x4 = __attribute__((ext_vector_type(4))) unsigned;
constexpr int SEQ = 2048, LDQKV = 2304, LDO = 1024;
constexpr int SLOT = 16384, NSLOT = 4;
constexpr int A_K = 0, A_V = NSLOT * SLOT, A_WS = 2 * NSLOT * SLOT, A_TAB = A_WS + 2048, A_END = A_TAB + 16384, A_XCH = 0;
constexpr float CS = 0.125f * 1.4426950408889634f;
constexpr float LOG2E = 1.4426950408889634f;
constexpr float THR = 8.f;
#define ATT_SBAR() __builtin_amdgcn_sched_barrier(0)
__device__ __forceinline__ int crow(int r, int hi) { return (r & 3) + 8 * (r >> 2) + 4 * hi; }
__device__ __forceinline__ unsigned cvtpk(float lo, float hi) { unsigned r; asm volatile("v_cvt_pk_bf16_f32 %0, %1, %2" : "=v"(r) : "v"(lo), "v"(hi)); return r; }
__device__ __forceinline__ int t5_bucket(int rel) { const int n = rel < 0 ? -rel : rel; int b = n; if (n >= 8) { b = (31 - __builtin_clz((unsigned)(n * n))) + 2; b = b > 15 ? 15 : b; } return (rel > 0 ? 16 : 0) + b; }

template <int KC> __device__ __forceinline__ int kswz(int row, int colB) { return row * (KC * 2) + (colB ^ ((row & 7) << 4)); }
template <int DV> __device__ __forceinline__ int v_st(int k, int c) { const int kk = (k & ~0xC) | ((k & 4) << 1) | ((k & 8) >> 1); return ((kk >> 3) * (DV / 32) + (c >> 5)) * 512 + ((kk & 7) * 32 + (c & 31)) * 2; }
__device__ __forceinline__ int v_rd_base(int lane) { return ((lane & 3) << 3) | (((lane >> 2) & 3) << 6) | (((lane >> 4) & 1) << 5) | (((lane >> 5) & 1) << 8); }
template <int OFF> __device__ __forceinline__ s16x4 tr_read(int vb) { s16x4 r; asm volatile("ds_read_b64_tr_b16 %0, %1 offset:%2" : "=&v"(r) : "v"(vb), "i"(OFF) : "memory"); return r; }

__device__ __forceinline__ void glds16(const void* sbase, unsigned voff, unsigned lds_dst) {
  unsigned keep;
  asm volatile("s_mov_b32 %0, m0\n\ts_mov_b32 m0, %3\n\ts_nop 0\n\tglobal_load_lds_dwordx4 %1, %2\n\ts_mov_b32 m0, %0" : "=&s"(keep) : "v"(voff), "s"(sbase), "s"(lds_dst) : "memory");
}
#define ATT_DECIDE(PMAX) do { if (__builtin_expect(__all((PMAX) - m_reg <= THR), 1)) { mn = m_reg; alpha = 1.f; } \
    else { mn = fmaxf(m_reg, (PMAX)); alpha = __builtin_amdgcn_exp2f(m_reg - mn); m_reg = mn; } } while (0)
__device__ __forceinline__ void partialSM(f32x16& p0, f32x16& p1, float& m_reg, float& alpha, bool use_tab, float cf, const float* tp) {
  float mn;
  if (use_tab) {
#pragma unroll
    for (int r = 0; r < 16; ++r) { const int co = (r & 3) + 8 * (r >> 2); p0[r] = fmaf(p0[r], CS, tp[co]); p1[r] = fmaf(p1[r], CS, tp[32 + co]); }
  }
  float mx0 = fmaxf(p0[0], p0[1]), mx1 = fmaxf(p0[2], p0[3]), mx2 = fmaxf(p1[0], p1[1]), mx3 = fmaxf(p1[2], p1[3]);
#pragma unroll
  for (int r = 4; r < 16; r += 4) { mx0 = fmaxf(fmaxf(mx0, p0[r]), p0[r + 1]); mx1 = fmaxf(fmaxf(mx1, p0[r + 2]), p0[r + 3]); mx2 = fmaxf(fmaxf(mx2, p1[r]), p1[r + 1]); mx3 = fmaxf(fmaxf(mx3, p1[r + 2]), p1[r + 3]); }
  float pmax = fmaxf(fmaxf(mx0, mx1), fmaxf(mx2, mx3));
  { auto rr = __builtin_amdgcn_permlane32_swap(__float_as_uint(pmax), __float_as_uint(pmax), false, false);
    pmax = fmaxf(__uint_as_float(rr[0]), __uint_as_float(rr[1])); }
  if (use_tab) {
    ATT_DECIDE(pmax);
#pragma unroll
    for (int r = 0; r < 16; ++r) { p0[r] = __builtin_amdgcn_exp2f(p0[r] - mn); p1[r] -= mn; }
  } else {
    pmax = fmaf(pmax, CS, cf);
    ATT_DECIDE(pmax);
    const float off = cf - mn;
#pragma unroll
    for (int r = 0; r < 16; ++r) { p0[r] = __builtin_amdgcn_exp2f(fmaf(p0[r], CS, off)); p1[r] = fmaf(p1[r], CS, off); }
  }
}
#undef ATT_DECIDE
__device__ __forceinline__ void sm_pre(f32x16& p0, f32x16& p1, const float* tp) {
#pragma unroll
  for (int r = 0; r < 16; ++r) { const int co = (r & 3) + 8 * (r >> 2); p0[r] = fmaf(p0[r], CS, tp[co]); p1[r] = fmaf(p1[r], CS, tp[32 + co]); }
}
__device__ __forceinline__ float sm_max(const f32x16& p0, const f32x16& p1) {
  float mx0 = fmaxf(p0[0], p0[1]), mx1 = fmaxf(p0[2], p0[3]), mx2 = fmaxf(p1[0], p1[1]), mx3 = fmaxf(p1[2], p1[3]);
#pragma unroll
  for (int r = 4; r < 16; r += 4) { mx0 = fmaxf(fmaxf(mx0, p0[r]), p0[r + 1]); mx1 = fmaxf(fmaxf(mx1, p0[r + 2]), p0[r + 3]); mx2 = fmaxf(fmaxf(mx2, p1[r]), p1[r + 1]); mx3 = fmaxf(fmaxf(mx3, p1[r + 2]), p1[r + 3]); }
  float pmax = fmaxf(fmaxf(mx0, mx1), fmaxf(mx2, mx3));
  auto rr = __builtin_amdgcn_permlane32_swap(__float_as_uint(pmax), __float_as_uint(pmax), false, false);
  return fmaxf(__uint_as_float(rr[0]), __uint_as_float(rr[1]));
}
__device__ __forceinline__ void sm_dec(float pmax, bool use_tab, float cf, float& m_reg, float& alpha, float& scale, float& off) {
  if (!use_tab) pmax = fmaf(pmax, CS, cf);
  const bool keep = __all(pmax - m_reg <= THR);
  const float mn = keep ? m_reg : fmaxf(m_reg, pmax);
  alpha = __builtin_amdgcn_exp2f(m_reg - mn); m_reg = mn;
  scale = use_tab ? 1.0f : CS; off = use_tab ? -mn : cf - mn;
}
template <int LO, int HI> __device__ __forceinline__ void sm_exp(f32x16& p0, float scale, float off) {
#pragma unroll
  for (int r = LO; r < HI; ++r) p0[r] = __builtin_amdgcn_exp2f(fmaf(p0[r], scale, off));
}
__device__ __forceinline__ void sm_sub(f32x16& p1, float scale, float off) {
#pragma unroll
  for (int r = 0; r < 16; ++r) p1[r] = fmaf(p1[r], scale, off);
}
__device__ __forceinline__ void finishSM(f32x16& p0, f32x16& p1, float alpha, float& l_reg, bf16x8& pa0, bf16x8& pa1, bf16x8& pa2, bf16x8& pa3) {
#pragma unroll
  for (int r = 0; r < 16; ++r) p1[r] = __builtin_amdgcn_exp2f(p1[r]);
  float ps0 = p0[0] + p0[1], ps1 = p0[2] + p0[3], ps2 = p1[0] + p1[1], ps3 = p1[2] + p1[3];
#pragma unroll
  for (int r = 4; r < 16; r += 4) { ps0 += p0[r] + p0[r + 1]; ps1 += p0[r + 2] + p0[r + 3]; ps2 += p1[r] + p1[r + 1]; ps3 += p1[r + 2] + p1[r + 3]; }
  float ps = (ps0 + ps1) + (ps2 + ps3);
  { auto rr = __builtin_amdgcn_permlane32_swap(__float_as_uint(ps), __float_as_uint(ps), false, false);
    ps = __uint_as_float(rr[0]) + __uint_as_float(rr[1]); }
  l_reg = l_reg * alpha + ps;
#define ATT_PK4(P, BASE, OUT) do { unsigned a0 = cvtpk(P[BASE + 0], P[BASE + 1]), a1 = cvtpk(P[BASE + 2], P[BASE + 3]);   \
    unsigned b0 = cvtpk(P[BASE + 4], P[BASE + 5]), b1 = cvtpk(P[BASE + 6], P[BASE + 7]);                              \
    auto r0 = __builtin_amdgcn_permlane32_swap(a0, b0, false, false); auto r1 = __builtin_amdgcn_permlane32_swap(a1, b1, false, false); \
    u32x4 w = {r0[0], r1[0], r0[1], r1[1]}; OUT = *reinterpret_cast<bf16x8*>(&w); } while (0)
  ATT_PK4(p0, 0, pa0); ATT_PK4(p0, 8, pa1); ATT_PK4(p1, 0, pa2); ATT_PK4(p1, 8, pa3);
#undef ATT_PK4
}
template <int KC> __device__ __forceinline__ void qkt(f32x16& p0, f32x16& p1, const char* Ks, const bf16x8* qr, int r32, int hi, int koffB) {
  p0 = f32x16{}; p1 = f32x16{};
#pragma unroll
  for (int d0 = 0; d0 < 4; ++d0) { const int cb = koffB + (d0 * 16 + hi * 8) * 2;
    const bf16x8 b0 = *reinterpret_cast<const bf16x8*>(Ks + kswz<KC>(r32, cb));
    const bf16x8 b1 = *reinterpret_cast<const bf16x8*>(Ks + kswz<KC>(32 + r32, cb));
    p0 = __builtin_amdgcn_mfma_f32_32x32x16_bf16(b0, qr[d0], p0, 0, 0, 0);
    p1 = __builtin_amdgcn_mfma_f32_32x32x16_bf16(b1, qr[d0], p1, 0, 0, 0); }
}
template <int DV, int D0> __device__ __forceinline__ void pv_one(f32x16& od, int vb, bf16x8 pa0, bf16x8 pa1, bf16x8 pa2, bf16x8 pa3) {
  constexpr int KS = (DV / 32) * 1024, HF = (DV / 32) * 512;
  const s16x4 l0 = tr_read<D0 * 512 + 0 * KS>(vb), h0 = tr_read<D0 * 512 + 0 * KS + HF>(vb), l1 = tr_read<D0 * 512 + 1 * KS>(vb), h1 = tr_read<D0 * 512 + 1 * KS + HF>(vb);
  const s16x4 l2 = tr_read<D0 * 512 + 2 * KS>(vb), h2 = tr_read<D0 * 512 + 2 * KS + HF>(vb), l3 = tr_read<D0 * 512 + 3 * KS>(vb), h3 = tr_read<D0 * 512 + 3 * KS + HF>(vb);
  asm volatile("s_waitcnt lgkmcnt(0)" ::: "memory"); ATT_SBAR();
#define ATT_PKV(L, H) (bf16x8){L[0], L[1], L[2], L[3], H[0], H[1], H[2], H[3]}
  od = __builtin_amdgcn_mfma_f32_32x32x16_bf16(pa0, ATT_PKV(l0, h0), od, 0, 0, 0);
  od = __builtin_amdgcn_mfma_f32_32x32x16_bf16(pa1, ATT_PKV(l1, h1), od, 0, 0, 0);
  od = __builtin_amdgcn_mfma_f32_32x32x16_bf16(pa2, ATT_PKV(l2, h2), od, 0, 0, 0);
  od = __builtin_amdgcn_mfma_f32_32x32x16_bf16(pa3, ATT_PKV(l3, h3), od, 0, 0, 0);
#undef ATT_PKV
}
template <int DV, int D0> __device__ __forceinline__ void pv_pair(f32x16& oa, f32x16& ob, int vb, bf16x8 pa0, bf16x8 pa1, bf16x8 pa2, bf16x8 pa3) {
  constexpr int KS = (DV / 32) * 1024, HF = (DV / 32) * 512, D1 = D0 + 1;
  const s16x4 l0 = tr_read<D0 * 512 + 0 * KS>(vb), h0 = tr_read<D0 * 512 + 0 * KS + HF>(vb), l1 = tr_read<D0 * 512 + 1 * KS>(vb), h1 = tr_read<D0 * 512 + 1 * KS + HF>(vb);
  const s16x4 l2 = tr_read<D0 * 512 + 2 * KS>(vb), h2 = tr_read<D0 * 512 + 2 * KS + HF>(vb), l3 = tr_read<D0 * 512 + 3 * KS>(vb), h3 = tr_read<D0 * 512 + 3 * KS + HF>(vb);
  const s16x4 m0 = tr_read<D1 * 512 + 0 * KS>(vb), n0 = tr_read<D1 * 512 + 0 * KS + HF>(vb), m1 = tr_read<D1 * 512 + 1 * KS>(vb), n1 = tr_read<D1 * 512 + 1 * KS + HF>(vb);
  const s16x4 m2 = tr_read<D1 * 512 + 2 * KS>(vb), n2 = tr_read<D1 * 512 + 2 * KS + HF>(vb), m3 = tr_read<D1 * 512 + 3 * KS>(vb), n3 = tr_read<D1 * 512 + 3 * KS + HF>(vb);
  asm volatile("s_waitcnt lgkmcnt(0)" ::: "memory"); ATT_SBAR();
#define ATT_PKV(L, H) (bf16x8){L[0], L[1], L[2], L[3], H[0], H[1], H[2], H[3]}
  oa = __builtin_amdgcn_mfma_f32_32x32x16_bf16(pa0, ATT_PKV(l0, h0), oa, 0, 0, 0); ob = __builtin_amdgcn_mfma_f32_32x32x16_bf16(pa0, ATT_PKV(m0, n0), ob, 0, 0, 0);
  oa = __builtin_amdgcn_mfma_f32_32x32x16_bf16(pa1, ATT_PKV(l1, h1), oa, 0, 0, 0); ob = __builtin_amdgcn_mfma_f32_32x32x16_bf16(pa1, ATT_PKV(m1, n1), ob, 0, 0, 0);
  oa = __builtin_amdgcn_mfma_f32_32x32x16_bf16(pa2, ATT_PKV(l2, h2), oa, 0, 0, 0); ob = __builtin_amdgcn_mfma_f32_32x32x16_bf16(pa2, ATT_PKV(m2, n2), ob, 0, 0, 0);
  oa = __builtin_amdgcn_mfma_f32_32x32x16_bf16(pa3, ATT_PKV(l3, h3), oa, 0, 0, 0); ob = __builtin_amdgcn_mfma_f32_32x32x16_bf16(pa3, ATT_PKV(m3, n3), ob, 0, 0, 0);
#undef ATT_PKV
}
template <int DV, int D0> __device__ __forceinline__ void pv_one2(f32x16& oa, f32x16& ob, int vb, bf16x8 pa0, bf16x8 pa1, bf16x8 pa2, bf16x8 pa3, bf16x8 pb0, bf16x8 pb1, bf16x8 pb2, bf16x8 pb3) {
  constexpr int KS = (DV / 32) * 1024, HF = (DV / 32) * 512;
  const s16x4 l0 = tr_read<D0 * 512 + 0 * KS>(vb), h0 = tr_read<D0 * 512 + 0 * KS + HF>(vb), l1 = tr_read<D0 * 512 + 1 * KS>(vb), h1 = tr_read<D0 * 512 + 1 * KS + HF>(vb);
  const s16x4 l2 = tr_read<D0 * 512 + 2 * KS>(vb), h2 = tr_read<D0 * 512 + 2 * KS + HF>(vb), l3 = tr_read<D0 * 512 + 3 * KS>(vb), h3 = tr_read<D0 * 512 + 3 * KS + HF>(vb);
  asm volatile("s_waitcnt lgkmcnt(0)" ::: "memory"); ATT_SBAR();
#define ATT_PKV(L, H) (bf16x8){L[0], L[1], L[2], L[3], H[0], H[1], H[2], H[3]}
  oa = __builtin_amdgcn_mfma_f32_32x32x16_bf16(pa0, ATT_PKV(l0, h0), oa, 0, 0, 0); ob = __builtin_amdgcn_mfma_f32_32x32x16_bf16(pb0, ATT_PKV(l0, h0), ob, 0, 0, 0);
  oa = __builtin_amdgcn_mfma_f32_32x32x16_bf16(pa1, ATT_PKV(l1, h1), oa, 0, 0, 0); ob = __builtin_amdgcn_mfma_f32_32x32x16_bf16(pb1, ATT_PKV(l1, h1), ob, 0, 0, 0);
  oa = __builtin_amdgcn_mfma_f32_32x32x16_bf16(pa2, ATT_PKV(l2, h2), oa, 0, 0, 0); ob = __builtin_amdgcn_mfma_f32_32x32x16_bf16(pb2, ATT_PKV(l2, h2), ob, 0, 0, 0);
  oa = __builtin_amdgcn_mfma_f32_32x32x16_bf16(pa3, ATT_PKV(l3, h3), oa, 0, 0, 0); ob = __builtin_amdgcn_mfma_f32_32x32x16_bf16(pb3, ATT_PKV(l3, h3), ob, 0, 0, 0);
#undef ATT_PKV
}
template <int KC> __device__ __forceinline__ void qkt2(f32x16& a0, f32x16& a1, f32x16& b0, f32x16& b1, const char* Ks, const bf16x8* qa, const bf16x8* qb, int r32, int hi) {
  a0 = f32x16{}; a1 = f32x16{}; b0 = f32x16{}; b1 = f32x16{};
#pragma unroll
  for (int d0 = 0; d0 < 4; ++d0) { const int cb = (d0 * 16 + hi * 8) * 2;
    const bf16x8 k0 = *reinterpret_cast<const bf16x8*>(Ks + kswz<KC>(r32, cb));
    const bf16x8 k1 = *reinterpret_cast<const bf16x8*>(Ks + kswz<KC>(32 + r32, cb));
    a0 = __builtin_amdgcn_mfma_f32_32x32x16_bf16(k0, qa[d0], a0, 0, 0, 0); b0 = __builtin_amdgcn_mfma_f32_32x32x16_bf16(k0, qb[d0], b0, 0, 0, 0);
    a1 = __builtin_amdgcn_mfma_f32_32x32x16_bf16(k1, qa[d0], a1, 0, 0, 0); b1 = __builtin_amdgcn_mfma_f32_32x32x16_bf16(k1, qb[d0], b1, 0, 0, 0); }
}
template <int DV> __device__ __forceinline__ void pv_all(f32x16* o, int vb, bf16x8 pa0, bf16x8 pa1, bf16x8 pa2, bf16x8 pa3) {
  pv_one<DV, 0>(o[0], vb, pa0, pa1, pa2, pa3); pv_one<DV, 1>(o[1], vb, pa0, pa1, pa2, pa3);
  if constexpr (DV == 128) { pv_one<DV, 2>(o[2], vb, pa0, pa1, pa2, pa3); pv_one<DV, 3>(o[3], vb, pa0, pa1, pa2, pa3); }
}

struct DiffParams { const float* lam_p; const float* subln; float lambda_init; };
template <bool DIFF>
__device__ __forceinline__ void attn_unit(char* lds, const bf16* __restrict__ qkv, bf16* __restrict__ obuf, int b, int h, int q0, const float* __restrict__ rel_bias, const float* __restrict__ sink, DiffParams dp, bool fill_tab) {
  constexpr int KC = DIFF ? 128 : 64, DV = DIFF ? 128 : 64, NT = DIFF ? 32 : 6, PW = DIFF ? 2 : 1, NO = DV / 32;
  int tid_ = threadIdx.x; asm volatile("" : "+v"(tid_));
  const int tid = tid_, lane = tid & 63, r32 = lane & 31, hi = lane >> 5; const int wid = __builtin_amdgcn_readfirstlane(tid >> 6);
  const int g = wid & 3, c = wid >> 2;
  const unsigned lds0 = (unsigned)(uintptr_t)lds;
  float* wsf = (float*)(lds + A_WS) + wid * 64; float* li_l = wsf; float* al_l = wsf + 32;
  float* tab = (float*)(lds + A_TAB);
  const long rowbase = (long)b * SEQ;
  const int qrow0 = DIFF ? q0 + 32 * g : q0 + 32 * c;
  const int hq = DIFF ? h : 4 * h + g;
  const int qcol = DIFF ? h * 128 + c * 64 : 1536 + hq * 64;
  const int kcol = DIFF ? 512 + h * 128 : 2048 + h * 64, vcol = DIFF ? 1024 + h * 128 : 2176 + h * 64;
  const int koffB = DIFF ? c * 128 : 0;
  const int kbase = DIFF ? 0 : q0 - 128;
  unsigned kofs[PW], vofs[PW];
#pragma unroll
  for (int i = 0; i < PW; ++i) { const int p = PW * wid + i;
    if constexpr (DIFF) { const int row = 4 * p + (lane >> 4), ch = (lane & 15) ^ (row & 7); kofs[i] = (unsigned)(row * (LDQKV * 2) + ch * 16);
      const int st = 2 * p + (lane >> 5), kk = (st >> 2) * 8 + ((lane >> 2) & 7), k = (kk & ~0xC) | ((kk & 4) << 1) | ((kk & 8) >> 1); vofs[i] = (unsigned)(k * (LDQKV * 2) + ((st & 3) * 32 + (lane & 3) * 8) * 2); }
    else { const int row = 8 * p + (lane >> 3), ch = (lane & 7) ^ (row & 7); kofs[i] = (unsigned)(row * (LDQKV * 2) + ch * 16);
      const int st = 2 * p + (lane >> 5), kk = (st >> 1) * 8 + ((lane >> 2) & 7), k = (kk & ~0xC) | ((kk & 4) << 1) | ((kk & 8) >> 1); vofs[i] = (unsigned)(k * (LDQKV * 2) + ((st & 1) * 32 + (lane & 3) * 8) * 2); } }
  const char* Kg = (const char*)(qkv + rowbase * LDQKV + kcol); const char* Vg = (const char*)(qkv + rowbase * LDQKV + vcol);
#define ATT_KPOS(t) (kbase + 64 * (t))
#define ATT_CLAMP(k) ((k) < 0 ? 0 : ((k) > SEQ - 64 ? SEQ - 64 : (k)))
#define ATT_DMA_K(t) do { const int kl_ = ATT_CLAMP(ATT_KPOS(t)); const char* sb_ = Kg + (long)kl_ * (LDQKV * 2); const unsigned ds_ = lds0 + A_K + ((t) % NSLOT) * SLOT + wid * (PW * 1024); \
    _Pragma("unroll") for (int i_ = 0; i_ < PW; ++i_) glds16(sb_, kofs[i_], (unsigned)__builtin_amdgcn_readfirstlane(ds_ + i_ * 1024)); } while (0)
#define ATT_DMA_V(t) do { const int kl_ = ATT_CLAMP(ATT_KPOS(t)); const char* sb_ = Vg + (long)kl_ * (LDQKV * 2); const unsigned ds_ = lds0 + A_V + ((t) % NSLOT) * SLOT + wid * (PW * 1024); \
    _Pragma("unroll") for (int i_ = 0; i_ < PW; ++i_) glds16(sb_, vofs[i_], (unsigned)__builtin_amdgcn_readfirstlane(ds_ + i_ * 1024)); } while (0)
#define ATT_WAITBAR(N) asm volatile("s_waitcnt vmcnt(" #N ") lgkmcnt(0)\n\ts_barrier" ::: "memory")
  ATT_DMA_K(0); ATT_DMA_V(0); ATT_DMA_K(1);
  if (fill_tab) {
  if constexpr (DIFF) {
    for (int i = tid; i < 4096; i += 512) tab[i] = rel_bias[t5_bucket(i - 2047) * 12 + h] * LOG2E;
  } else {
    for (int i = tid; i < 2048; i += 512) { const int hl = i >> 9, rel = (i & 511) - 256; const bool in = rel >= -128 && rel <= 128;
      tab[i] = in ? rel_bias[t5_bucket(rel) * 12 + 4 + 4 * h + hl] * LOG2E : -1e30f; }
  }
  }
  const float cpos = DIFF ? rel_bias[31 * 12 + h] * LOG2E : 0.f, cneg = DIFF ? rel_bias[15 * 12 + h] * LOG2E : 0.f;
  const int TOFF = DIFF ? 2047 : 256 + g * 512;
  bf16x8 qr[4];
  { const bf16* Qw = qkv + (rowbase + qrow0 + r32) * LDQKV + qcol + hi * 8;
#pragma unroll
    for (int d0 = 0; d0 < 4; ++d0) qr[d0] = *reinterpret_cast<const bf16x8*>(Qw + d0 * 16); }
  float m_reg, l_reg;
  if constexpr (DIFF) { m_reg = -1e30f; l_reg = 0.f; } else { m_reg = sink[hq] * LOG2E; l_reg = 1.f; }
  f32x16 o[NO];
#pragma unroll
  for (int d = 0; d < NO; ++d) o[d] = f32x16{};
  const int vb0 = (int)lds0 + A_V + v_rd_base(lane);
  const char* Kl = lds + A_K;
#define ATT_RESC(a) do { if (__any((a) < 1.f)) { if (hi == 0) al_l[r32] = (a); asm volatile("s_waitcnt lgkmcnt(0)" ::: "memory"); \
    _Pragma("unroll") for (int d_ = 0; d_ < NO; ++d_) _Pragma("unroll") for (int r_ = 0; r_ < 16; ++r_) o[d_][r_] *= al_l[crow(r_, hi)]; } } while (0)
#define ATT_MODE(t, UT, CF, TP) do { const int k0_ = ATT_KPOS(t); \
    if constexpr (DIFF) { const int rmin_ = k0_ - (qrow0 + 31), rmax_ = k0_ + 63 - qrow0; UT = !(rmin_ >= 128 || rmax_ <= -128); CF = rmin_ >= 128 ? cpos : cneg; } \
    else { UT = (k0_ >= 0 && k0_ < SEQ); CF = -1e30f; } \
    TP = tab + (k0_ - (qrow0 + r32) + TOFF + 4 * hi); } while (0)
#define ATT_STEP(T, C0, C1, AC, P0, P1, AP) do { bool ut_; float cf_; const float* tp_; \
    qkt<KC>(C0, C1, Kl + ((T) % NSLOT) * SLOT, qr, r32, hi, koffB); \
    if constexpr (DIFF) { if ((T) + 1 < NT) { ATT_DMA_K((T) + 3); ATT_DMA_V((T) + 2); } } \
    finishSM(P0, P1, AP, l_reg, pa0, pa1, pa2, pa3); \
    ATT_MODE(T, ut_, cf_, tp_); \
    if constexpr (DIFF) { const int vb_ = vb0 + (((T) - 1) % NSLOT) * SLOT; float sc_, of_; \
      if (ut_) sm_pre(C0, C1, tp_); \
      ATT_SBAR(); \
      pv_pair<DV, 0>(o[0], o[1], vb_, pa0, pa1, pa2, pa3); const float pm_ = sm_max(C0, C1); sm_dec(pm_, ut_, cf_, m_reg, AC, sc_, of_); sm_exp<0, 8>(C0, sc_, of_); \
      pv_pair<DV, 2>(o[2], o[3], vb_, pa0, pa1, pa2, pa3); sm_exp<8, 16>(C0, sc_, of_); sm_sub(C1, sc_, of_); \
    } else { ATT_SBAR(); \
      pv_all<DV>(o, vb0 + (((T) - 1) % NSLOT) * SLOT, pa0, pa1, pa2, pa3); \
      partialSM(C0, C1, m_reg, AC, ut_, cf_, tp_); } \
    ATT_RESC(AC); } while (0)
  f32x16 pA0, pA1, pB0, pB1; float alA, alB; bf16x8 pa0, pa1, pa2, pa3;
  ATT_WAITBAR(0);
  ATT_DMA_V(1); ATT_DMA_K(2); ATT_DMA_K(3); ATT_DMA_V(2);
  { bool ut_; float cf_; const float* tp_; qkt<KC>(pA0, pA1, Kl, qr, r32, hi, koffB); ATT_MODE(0, ut_, cf_, tp_); partialSM(pA0, pA1, m_reg, alA, ut_, cf_, tp_); }
  if constexpr (DIFF) ATT_WAITBAR(8); else ATT_WAITBAR(4);
  int t = 1;
  for (; t + 2 < NT; t += 2) {
    if constexpr (!DIFF) { ATT_DMA_K(t + 3); ATT_DMA_V(t + 2); }
    ATT_STEP(t, pB0, pB1, alB, pA0, pA1, alA);
    if constexpr (DIFF) ATT_WAITBAR(8); else ATT_WAITBAR(4);
    if constexpr (!DIFF) { ATT_DMA_K(t + 4); ATT_DMA_V(t + 3); }
    ATT_STEP(t + 1, pA0, pA1, alA, pB0, pB1, alB);
    if constexpr (DIFF) ATT_WAITBAR(8); else ATT_WAITBAR(4);
  }
  ATT_STEP(t, pB0, pB1, alB, pA0, pA1, alA);
  ATT_WAITBAR(0);
  finishSM(pB0, pB1, alB, l_reg, pa0, pa1, pa2, pa3); ATT_SBAR();
  pv_all<DV>(o, vb0 + ((NT - 1) % NSLOT) * SLOT, pa0, pa1, pa2, pa3);
  if (hi == 0) li_l[r32] = l_reg; asm volatile("s_waitcnt lgkmcnt(0)" ::: "memory");
#pragma unroll
  for (int r = 0; r < 16; ++r) { const float rl = __builtin_amdgcn_rcpf(li_l[crow(r, hi)]);
#pragma unroll
    for (int d = 0; d < NO; ++d) o[d][r] *= rl; }
  bf16* Ob = obuf + (rowbase + qrow0) * LDO + (DIFF ? h * 128 : 512 + hq * 64);
  unsigned char* Ob8 = (unsigned char*)obuf + (rowbase + qrow0) * LDO + (DIFF ? h * 128 : 512 + hq * 64);
  if constexpr (DIFF) {
    float s1 = dp.lam_p[lane] * dp.lam_p[64 + lane], s2 = dp.lam_p[128 + lane] * dp.lam_p[192 + lane];
#pragma unroll
    for (int of = 1; of < 64; of <<= 1) { s1 += __shfl_xor(s1, of); s2 += __shfl_xor(s2, of); }
    const float lam = __expf(s1) - __expf(s2) + dp.lambda_init;
    float* xch = (float*)(lds + A_XCH) + g * 4096;
    ATT_WAITBAR(0);
    if (c == 1) {
#pragma unroll
      for (int d = 0; d < NO; ++d)
#pragma unroll
        for (int r = 0; r < 16; ++r) xch[(d * 16 + r) * 64 + lane] = o[d][r] * lam;
    }
    ATT_WAITBAR(0);
    if (c == 0) {
      float gs[NO];
#pragma unroll
      for (int d = 0; d < NO; ++d) gs[d] = dp.subln[32 * d + r32] * (1.0f - dp.lambda_init);
#pragma unroll
      for (int r = 0; r < 16; ++r)
#pragma unroll
        for (int d = 0; d < NO; ++d) o[d][r] -= xch[(d * 16 + r) * 64 + lane];
      asm volatile("s_waitcnt lgkmcnt(0)" ::: "memory");
#pragma unroll
      for (int r = 0; r < 16; ++r) {
        float ss = 0.f;
#pragma unroll
        for (int d = 0; d < NO; ++d) ss += o[d][r] * o[d][r];
#pragma unroll
        for (int of = 1; of < 32; of <<= 1) ss += __shfl_xor(ss, of);
        const float rs = rsqrtf(ss * (1.0f / 128.0f) + 1e-6f);
#pragma unroll
        for (int d = 0; d < NO; ++d) xch[crow(r, hi) * 128 + 32 * d + r32] = o[d][r] * rs * gs[d];
      }
      asm volatile("s_waitcnt lgkmcnt(0)" ::: "memory");
#pragma unroll
      for (int i = 0; i < 4; ++i) { const int row = 8 * i + (lane >> 3), c16 = (lane & 7) * 16; const float* xp = xch + row * 128 + c16;
        const f32x4 u0 = *(const f32x4*)(xp) * pg8::O8_MUL, u1 = *(const f32x4*)(xp + 4) * pg8::O8_MUL, u2 = *(const f32x4*)(xp + 8) * pg8::O8_MUL, u3 = *(const f32x4*)(xp + 12) * pg8::O8_MUL;
        u32x4 w; w.x = pg8::pk4_fp8(u0[0], u0[1], u0[2], u0[3]); w.y = pg8::pk4_fp8(u1[0], u1[1], u1[2], u1[3]); w.z = pg8::pk4_fp8(u2[0], u2[1], u2[2], u2[3]); w.w = pg8::pk4_fp8(u3[0], u3[1], u3[2], u3[3]);
        *(u32x4*)(Ob8 + (long)row * LDO + c16) = w; }
    }
  } else {
#pragma unroll
    for (int r = 0; r < 16; ++r) { bf16* orow = Ob + (long)crow(r, hi) * LDO + r32;
#pragma unroll
      for (int d = 0; d < NO; ++d) orow[32 * d] = (bf16)(cvtpk(o[d][r], 0.f) & 0xffffu); }
  }
  ATT_WAITBAR(0);
#undef ATT_KPOS
#undef ATT_CLAMP
#undef ATT_DMA_K
#undef ATT_DMA_V
#undef ATT_WAITBAR
#undef ATT_RESC
#undef ATT_MODE
#undef ATT_STEP
}

constexpr int W_K = 0, W_V = 6 * 8192;
__device__ __forceinline__ void attn_unit_win2(char* lds, const bf16* __restrict__ qkv, bf16* __restrict__ obuf, int b, int h, int q0, const float* __restrict__ rel_bias, const float* __restrict__ sink, bool fill_tab) {
  constexpr int KC = 64, DV = 64;
  int tid_ = threadIdx.x; asm volatile("" : "+v"(tid_));
  const int tid = tid_, lane = tid & 63, r32 = lane & 31, hi = lane >> 5; const int wid = __builtin_amdgcn_readfirstlane(tid >> 6);
  const int g = wid & 3, rp = wid >> 2, hq = 4 * h + g;
  const unsigned lds0 = (unsigned)(uintptr_t)lds;
  float* wsf = (float*)(lds + A_WS) + wid * 64; float* li_l = wsf; float* al_l = wsf + 32;
  float* tab = (float*)(lds + A_TAB);
  const long rowbase = (long)b * SEQ;
  const int kbase = q0 - 128;
  const char* Kg = (const char*)(qkv + rowbase * LDQKV + 2048 + h * 64); const char* Vg = (const char*)(qkv + rowbase * LDQKV + 2176 + h * 64);
#pragma unroll
  for (int i = 0; i < 6; ++i) { const int pi = wid + 8 * i, tile = pi >> 3, pc = pi & 7; const int k0 = kbase + 64 * tile;
    if (k0 >= 0 && k0 < SEQ) {
      const int row = 8 * pc + (lane >> 3), ch = (lane & 7) ^ (row & 7);
      glds16(Kg + (long)k0 * (LDQKV * 2), (unsigned)(row * (LDQKV * 2) + ch * 16), (unsigned)__builtin_amdgcn_readfirstlane(lds0 + W_K + tile * 8192 + pc * 1024));
      const int st = 2 * pc + (lane >> 5), kk = (st >> 1) * 8 + ((lane >> 2) & 7), k = (kk & ~0xC) | ((kk & 4) << 1) | ((kk & 8) >> 1);
      glds16(Vg + (long)k0 * (LDQKV * 2), (unsigned)(k * (LDQKV * 2) + ((st & 1) * 32 + (lane & 3) * 8) * 2), (unsigned)__builtin_amdgcn_readfirstlane(lds0 + W_V + tile * 8192 + pc * 1024)); } }
  if (fill_tab) {
    for (int i = tid; i < 2048; i += 512) { const int hl = i >> 9, rel = (i & 511) - 256; const bool in = rel >= -128 && rel <= 128;
      tab[i] = in ? rel_bias[t5_bucket(rel) * 12 + 4 + 4 * h + hl] * LOG2E : -1e30f; } }
  const int qrowA = q0 + 64 * rp, qrowB = qrowA + 32;
  bf16x8 qa[4], qb[4];
  { const bf16* Qw = qkv + (rowbase + qrowA + r32) * LDQKV + 1536 + hq * 64 + hi * 8;
#pragma unroll
    for (int d0 = 0; d0 < 4; ++d0) { qa[d0] = *reinterpret_cast<const bf16x8*>(Qw + d0 * 16); qb[d0] = *reinterpret_cast<const bf16x8*>(Qw + 32 * LDQKV + d0 * 16); } }
  const float m0 = sink[hq] * LOG2E;
  float mA = m0, lA = 1.f, mB = m0, lB = 1.f;
  f32x16 oA[2], oB[2];
#pragma unroll
  for (int d = 0; d < 2; ++d) { oA[d] = f32x16{}; oB[d] = f32x16{}; }
  asm volatile("s_waitcnt vmcnt(0) lgkmcnt(0)\n\ts_barrier" ::: "memory");
  const int t0 = rp;
  const float* tpb = tab + g * 512 + 256 + 4 * hi - r32;
#define ATW_RESC(O, a) do { if (__any((a) < 1.f)) { if (hi == 0) al_l[r32] = (a); asm volatile("s_waitcnt lgkmcnt(0)" ::: "memory"); \
    _Pragma("unroll") for (int d_ = 0; d_ < 2; ++d_) _Pragma("unroll") for (int r_ = 0; r_ < 16; ++r_) O[d_][r_] *= al_l[crow(r_, hi)]; asm volatile("s_waitcnt lgkmcnt(0)" ::: "memory"); } } while (0)
#pragma unroll 1
  for (int tt = 0; tt < 5; ++tt) {
    const int t = t0 + tt, k0 = kbase + 64 * t;
    if (k0 < 0 || k0 >= SEQ) continue;
    const char* Ks = lds + W_K + t * 8192; const int vb = (int)lds0 + W_V + t * 8192 + v_rd_base(lane);
    f32x16 a0, a1, b0, b1; float alA, alB, sc, of; bf16x8 pa0, pa1, pa2, pa3, pb0, pb1, pb2, pb3;
    qkt2<KC>(a0, a1, b0, b1, Ks, qa, qb, r32, hi);
    sm_pre(a0, a1, tpb + (k0 - qrowA));
    { const float pm = sm_max(a0, a1); sm_dec(pm, true, 0.f, mA, alA, sc, of); sm_exp<0, 16>(a0, sc, of); sm_sub(a1, sc, of); finishSM(a0, a1, alA, lA, pa0, pa1, pa2, pa3); }
    sm_pre(b0, b1, tpb + (k0 - qrowB));
    { const float pm = sm_max(b0, b1); sm_dec(pm, true, 0.f, mB, alB, sc, of); sm_exp<0, 16>(b0, sc, of); sm_sub(b1, sc, of); finishSM(b0, b1, alB, lB, pb0, pb1, pb2, pb3); }
    ATW_RESC(oA, alA); ATW_RESC(oB, alB);
    ATT_SBAR();
    pv_one2<DV, 0>(oA[0], oB[0], vb, pa0, pa1, pa2, pa3, pb0, pb1, pb2, pb3); pv_one2<DV, 1>(oA[1], oB[1], vb, pa0, pa1, pa2, pa3, pb0, pb1, pb2, pb3);
  }
#undef ATW_RESC
  if (hi == 0) { li_l[r32] = lA; al_l[r32] = lB; }
  asm volatile("s_waitcnt lgkmcnt(0)\n\ts_barrier" ::: "memory");
  float* stg = (float*)(lds + W_K) + wid * 2048;
  unsigned char* Ob8 = (unsigned char*)obuf + (rowbase + qrowA) * LDO + 512 + hq * 64;
#pragma unroll
  for (int task = 0; task < 2; ++task) {
#pragma unroll
    for (int r = 0; r < 16; ++r) { const float rl = __builtin_amdgcn_rcpf(task == 0 ? li_l[crow(r, hi)] : al_l[crow(r, hi)]);
#pragma unroll
      for (int d = 0; d < 2; ++d) stg[crow(r, hi) * 64 + 32 * d + r32] = (task == 0 ? oA[d][r] : oB[d][r]) * rl; }
    asm volatile("s_waitcnt lgkmcnt(0)" ::: "memory");
#pragma unroll
    for (int i = 0; i < 2; ++i) { const int row = 16 * i + (lane >> 2), c16 = (lane & 3) * 16; const float* xp = stg + row * 64 + c16;
      const f32x4 u0 = *(const f32x4*)(xp) * pg8::O8_MUL, u1 = *(const f32x4*)(xp + 4) * pg8::O8_MUL, u2 = *(const f32x4*)(xp + 8) * pg8::O8_MUL, u3 = *(const f32x4*)(xp + 12) * pg8::O8_MUL;
      u32x4 w; w.x = pg8::pk4_fp8(u0[0], u0[1], u0[2], u0[3]); w.y = pg8::pk4_fp8(u1[0], u1[1], u1[2], u1[3]); w.z = pg8::pk4_fp8(u2[0], u2[1], u2[2], u2[3]); w.w = pg8::pk4_fp8(u3[0], u3[1], u3[2], u3[3]);
      *(u32x4*)(Ob8 + (long)(32 * task + row) * LDO + c16) = w; }
    asm volatile("s_waitcnt lgkmcnt(0)" ::: "memory");
  }
  asm volatile("s_waitcnt vmcnt(0) lgkmcnt(0)\n\ts_barrier" ::: "memory");
}
constexpr int A_HX = A_END, A_AL = A_HX + 4 * 2 * 4096, A_FL = A_AL + 4 * 2 * 128, A_LI = A_FL + 64, A_END2 = A_LI + 4 * 128;
__device__ __forceinline__ void attn_unit_diff_split(char* lds, const bf16* __restrict__ qkv, bf16* __restrict__ obuf, int b, int h, int q0, const float* __restrict__ rel_bias, DiffParams dp, bool fill_tab) {
  constexpr int KC = 128, DV = 128, NT = 32, PW = 2, NO = 4;
  int tid_ = threadIdx.x; asm volatile("" : "+v"(tid_));
  const int tid = tid_, lane = tid & 63, r32 = lane & 31, hi = lane >> 5; const int wid = __builtin_amdgcn_readfirstlane(tid >> 6);
  const bool is_s = wid < 4; const int p = wid & 3, rg = p & 1, c = p >> 1;
  const unsigned lds0 = (unsigned)(uintptr_t)lds;
  float* tab = (float*)(lds + A_TAB);
  const long rowbase = (long)b * SEQ;
  const int qrow0 = q0 + 32 * rg;
  const int qcol = h * 128 + c * 64, kcol = 512 + h * 128, vcol = 1024 + h * 128, koffB = c * 128;
  unsigned kofs[PW], vofs[PW];
#pragma unroll
  for (int i = 0; i < PW; ++i) { const int pc = PW * wid + i;
    const int row = 4 * pc + (lane >> 4), ch = (lane & 15) ^ (row & 7); kofs[i] = (unsigned)(row * (LDQKV * 2) + ch * 16);
    const int st = 2 * pc + (lane >> 5), kk = (st >> 2) * 8 + ((lane >> 2) & 7), k = (kk & ~0xC) | ((kk & 4) << 1) | ((kk & 8) >> 1); vofs[i] = (unsigned)(k * (LDQKV * 2) + ((st & 3) * 32 + (lane & 3) * 8) * 2); }
  const char* Kg = (const char*)(qkv + rowbase * LDQKV + kcol); const char* Vg = (const char*)(qkv + rowbase * LDQKV + vcol);
#define ATS_DMA_K(t) do { const char* sb_ = Kg + (long)(64 * (t)) * (LDQKV * 2); const unsigned ds_ = lds0 + A_K + ((t) % NSLOT) * SLOT + wid * (PW * 1024); \
    _Pragma("unroll") for (int i_ = 0; i_ < PW; ++i_) glds16(sb_, kofs[i_], (unsigned)__builtin_amdgcn_readfirstlane(ds_ + i_ * 1024)); } while (0)
#define ATS_DMA_V(t) do { const char* sb_ = Vg + (long)(64 * (t)) * (LDQKV * 2); const unsigned ds_ = lds0 + A_V + ((t) % NSLOT) * SLOT + wid * (PW * 1024); \
    _Pragma("unroll") for (int i_ = 0; i_ < PW; ++i_) glds16(sb_, vofs[i_], (unsigned)__builtin_amdgcn_readfirstlane(ds_ + i_ * 1024)); } while (0)
#define ATS_WAITBAR(N) asm volatile("s_waitcnt vmcnt(" #N ") lgkmcnt(0)\n\ts_barrier" ::: "memory")
  ATS_DMA_K(0); ATS_DMA_V(0); ATS_DMA_K(1);
  if (fill_tab) { for (int i = tid; i < 4096; i += 512) tab[i] = rel_bias[t5_bucket(i - 2047) * 12 + h] * LOG2E; }
  const float cpos = rel_bias[31 * 12 + h] * LOG2E, cneg = rel_bias[15 * 12 + h] * LOG2E;
  char* hx = lds + A_HX + p * 8192; float* alx = (float*)(lds + A_AL) + p * 64; unsigned* flx = (unsigned*)(lds + A_FL) + p * 2; float* lix = (float*)(lds + A_LI) + p * 32;
  const char* Kl = lds + A_K;
#define ATS_HAND(T, AP, F0, F1, F2, F3) do { char* hs_ = hx + ((T) & 1) * 4096 + lane * 16; \
    *(bf16x8*)(hs_) = F0; *(bf16x8*)(hs_ + 1024) = F1; *(bf16x8*)(hs_ + 2048) = F2; *(bf16x8*)(hs_ + 3072) = F3; \
    if (hi == 0) alx[((T) & 1) * 32 + r32] = (AP); \
    const bool any_ = __any((AP) < 1.f); if (lane == 0) flx[(T) & 1] = any_ ? 1u : 0u; } while (0)
#define ATS_MODE(T, UT, CF, TP) do { const int k0_ = 64 * (T); const int rmin_ = k0_ - (qrow0 + 31), rmax_ = k0_ + 63 - qrow0; UT = !(rmin_ >= 128 || rmax_ <= -128); CF = rmin_ >= 128 ? cpos : cneg; \
    TP = tab + (k0_ - (qrow0 + r32) + 2047 + 4 * hi); } while (0)
#define ATS_STEP(T, C0, C1, AC, P0, P1, AP) do { bool ut_; float cf_; const float* tp_; bf16x8 f0_, f1_, f2_, f3_; \
    qkt<KC>(C0, C1, Kl + ((T) % NSLOT) * SLOT, qr, r32, hi, koffB); \
    finishSM(P0, P1, AP, l_reg, f0_, f1_, f2_, f3_); \
    ATS_HAND((T) - 1, AP, f0_, f1_, f2_, f3_); \
    ATS_MODE(T, ut_, cf_, tp_); partialSM(C0, C1, m_reg, AC, ut_, cf_, tp_); } while (0)
#define ATS_PV(T) do { const float* as_ = alx + ((T) & 1) * 32; \
    if (flx[(T) & 1] != 0u) { _Pragma("unroll") for (int d_ = 0; d_ < NO; ++d_) _Pragma("unroll") for (int r_ = 0; r_ < 16; ++r_) o[d_][r_] *= as_[crow(r_, hi)]; } \
    const char* hs_ = hx + ((T) & 1) * 4096 + lane * 16; \
    const bf16x8 f0_ = *(const bf16x8*)(hs_), f1_ = *(const bf16x8*)(hs_ + 1024), f2_ = *(const bf16x8*)(hs_ + 2048), f3_ = *(const bf16x8*)(hs_ + 3072); \
    pv_all<DV>(o, vb0 + ((T) % NSLOT) * SLOT, f0_, f1_, f2_, f3_); } while (0)
  ATS_WAITBAR(0);
  if (is_s) {
    bf16x8 qr[4]; float m_reg = -1e30f, l_reg = 0.f;
    { const bf16* Qw = qkv + (rowbase + qrow0 + r32) * LDQKV + qcol + hi * 8;
#pragma unroll
      for (int d0 = 0; d0 < 4; ++d0) qr[d0] = *reinterpret_cast<const bf16x8*>(Qw + d0 * 16); }
    f32x16 pA0, pA1, pB0, pB1; float alA = 1.f, alB = 1.f;
    ATS_DMA_K(2);
    { bool ut_; float cf_; const float* tp_; qkt<KC>(pA0, pA1, Kl, qr, r32, hi, koffB); ATS_MODE(0, ut_, cf_, tp_); partialSM(pA0, pA1, m_reg, alA, ut_, cf_, tp_); }
    ATS_WAITBAR(2);
    ATS_DMA_K(3); ATS_DMA_V(1);
    ATS_STEP(1, pB0, pB1, alB, pA0, pA1, alA);
    ATS_WAITBAR(4);
    int t = 2;
    for (; t + 2 < NT; t += 2) {
      ATS_DMA_K(t + 2); ATS_DMA_V(t); ATS_STEP(t, pA0, pA1, alA, pB0, pB1, alB); ATS_WAITBAR(4);
      ATS_DMA_K(t + 3); ATS_DMA_V(t + 1); ATS_STEP(t + 1, pB0, pB1, alB, pA0, pA1, alA); ATS_WAITBAR(4);
    }
    ATS_DMA_V(t); ATS_STEP(t, pA0, pA1, alA, pB0, pB1, alB); ATS_WAITBAR(2);
    ATS_DMA_V(t + 1); ATS_STEP(t + 1, pB0, pB1, alB, pA0, pA1, alA); ATS_WAITBAR(2);
    { bf16x8 f0_, f1_, f2_, f3_; finishSM(pB0, pB1, alB, l_reg, f0_, f1_, f2_, f3_); ATS_HAND(NT - 1, alB, f0_, f1_, f2_, f3_); if (hi == 0) lix[r32] = l_reg; }
    ATS_WAITBAR(0);
    ATS_WAITBAR(0);
    ATS_WAITBAR(0);
    ATS_WAITBAR(0);
  } else {
    f32x16 o[NO];
#pragma unroll
    for (int d = 0; d < NO; ++d) o[d] = f32x16{};
    const int vb0 = (int)lds0 + A_V + v_rd_base(lane);
    ATS_DMA_K(2); ATS_WAITBAR(2);
    ATS_DMA_K(3); ATS_DMA_V(1); ATS_WAITBAR(4);
    int t = 2;
    for (; t + 2 < NT; t += 2) {
      ATS_DMA_K(t + 2); ATS_DMA_V(t); ATS_PV(t - 2); ATS_WAITBAR(4);
      ATS_DMA_K(t + 3); ATS_DMA_V(t + 1); ATS_PV(t - 1); ATS_WAITBAR(4);
    }
    ATS_DMA_V(t); ATS_PV(t - 2); ATS_WAITBAR(2);
    ATS_DMA_V(t + 1); ATS_PV(t - 1); ATS_WAITBAR(2);
    ATS_PV(NT - 2); ATS_WAITBAR(0);
    ATS_PV(NT - 1); ATS_WAITBAR(0);
    float lam;
    { float s1 = dp.lam_p[lane] * dp.lam_p[64 + lane], s2 = dp.lam_p[128 + lane] * dp.lam_p[192 + lane];
#pragma unroll
      for (int of = 1; of < 64; of <<= 1) { s1 += __shfl_xor(s1, of); s2 += __shfl_xor(s2, of); }
      lam = __expf(s1) - __expf(s2) + dp.lambda_init; }
    float* xch = (float*)(lds + A_XCH) + rg * 4096;
#pragma unroll
    for (int r = 0; r < 16; ++r) { const float rl = __builtin_amdgcn_rcpf(lix[crow(r, hi)]);
#pragma unroll
      for (int d = 0; d < NO; ++d) o[d][r] *= rl; }
    if (c == 1) {
#pragma unroll
      for (int d = 0; d < NO; ++d)
#pragma unroll
        for (int r = 0; r < 16; ++r) xch[(d * 16 + r) * 64 + lane] = o[d][r] * lam;
    }
    ATS_WAITBAR(0);
    if (c == 0) {
      bf16* Ob = obuf + (rowbase + qrow0) * LDO + h * 128;
      float gs[NO];
#pragma unroll
      for (int d = 0; d < NO; ++d) gs[d] = dp.subln[32 * d + r32] * (1.0f - dp.lambda_init);
#pragma unroll
      for (int r = 0; r < 16; ++r) {
        float ss = 0.f;
#pragma unroll
        for (int d = 0; d < NO; ++d) { o[d][r] -= xch[(d * 16 + r) * 64 + lane]; ss += o[d][r] * o[d][r]; }
#pragma unroll
        for (int of = 1; of < 32; of <<= 1) ss += __shfl_xor(ss, of);
        const float rs = rsqrtf(ss * (1.0f / 128.0f) + 1e-6f);
        bf16* orow = Ob + (long)crow(r, hi) * LDO + r32;
#pragma unroll
        for (int d = 0; d < NO; ++d) orow[32 * d] = (bf16)(cvtpk(o[d][r] * rs * gs[d], 0.f) & 0xffffu);
      }
    }
    ATS_WAITBAR(0);
  }
#undef ATS_DMA_K
#undef ATS_DMA_V
#undef ATS_WAITBAR
#undef ATS_HAND
#undef ATS_MODE
#undef ATS_STEP
#undef ATS_PV
}
#undef ATT_SBAR
}

#ifndef PH_MASK
#define PH_MASK 0xFFFF
#endif
#define PH(k) ((PH_MASK >> (k)) & 1)
#ifndef REP_MASK
#define REP_MASK 0
#endif
#define REPS(k) (1 + ((REP_MASK >> (k)) & 1))
constexpr int NWAVES = 8;
constexpr int NBATCH = 16, SEQ = 2048, DM = 1024, NTOK = NBATCH * SEQ, DEPTH = 2;
constexpr int INC = 4352, QKVC = 2304, GATEC = 2048, NEXP = 32, FH = 512;
constexpr float RMS_EPS = 1e-6f;
constexpr size_t MiB = 1u << 20;
constexpr size_t WS_CTL = 0, CTL_ZERO_BYTES = 1 * MiB;
constexpr size_t WS_TOK = 2 * MiB;
constexpr size_t WS_RS = 3 * MiB;
constexpr size_t WS_WIN = 4 * MiB;
constexpr size_t WS_PT = 21 * MiB;
constexpr size_t WS_WO = 25 * MiB;
constexpr size_t WS_RTW = 29 * MiB;
constexpr size_t WS_WGU = 32 * MiB;
constexpr size_t WS_WD = 64 * MiB;
constexpr size_t WS_H8 = 80 * MiB;
constexpr size_t WS_WG8 = 112 * MiB;
constexpr size_t WS_H = 128 * MiB;
constexpr size_t WS_QKV = 192 * MiB;
constexpr size_t WS_GATES = 336 * MiB;
constexpr size_t WS_WGU1 = 400 * MiB, WS_WD1 = 432 * MiB;
constexpr size_t WS_O = 464 * MiB;
constexpr size_t WS_LIST = 528 * MiB;
constexpr size_t WS_END = 532 * MiB;
constexpr int RMAX_TILES = 288;
#ifndef FILL_P1
#define FILL_P1 2
#endif
#ifndef FILL_P6
#define FILL_P6 2
#endif
#ifndef FILL_P7
#define FILL_P7 1
#endif
constexpr int CW_BAR = 4096;
constexpr int CW_CNT = 8192;
constexpr int LDS_SCRATCH = 155648;
constexpr int LDS_MISC = LDS_SCRATCH;
constexpr int LDS_BYTES = 163840;
constexpr int MW_PAD = 16, MW_NT = 50, MW_TILE = 64, MW_CNT = 360, MW_ROW = 512, ROWTAB_UNITS = 6;

#define GAS __attribute__((address_space(1)))
#define LAS __attribute__((address_space(3)))
typedef unsigned short bf16;
typedef unsigned v4u __attribute__((ext_vector_type(4)));
typedef unsigned v2u __attribute__((ext_vector_type(2)));
typedef float f32x4 __attribute__((ext_vector_type(4)));
#define RLX_AGENT __ATOMIC_RELAXED, __HIP_MEMORY_SCOPE_AGENT
#define LDS_WAIT() asm volatile("s_waitcnt lgkmcnt(0)" ::: "memory")
__device__ __forceinline__ unsigned f2bf(float f) { unsigned u = __builtin_bit_cast(unsigned, f); return (u + 0x7fffu + ((u >> 16) & 1u)) >> 16; }
__device__ __forceinline__ unsigned pk2(float lo, float hi) { return f2bf(lo) | (f2bf(hi) << 16); }
__device__ __forceinline__ float bflo(unsigned w) { return __uint_as_float(w << 16); }
__device__ __forceinline__ float bfhi(unsigned w) { return __uint_as_float(w & 0xffff0000u); }
typedef float f32x2v __attribute__((ext_vector_type(2)));
__device__ __forceinline__ f32x4 fp8x4_to_f32(unsigned w) { const f32x2v lo = __builtin_amdgcn_cvt_pk_f32_fp8((int)w, false), hi = __builtin_amdgcn_cvt_pk_f32_fp8((int)w, true); return (f32x4){lo.x, lo.y, hi.x, hi.y}; }
__device__ __forceinline__ float wave_sum(float v) {
#pragma unroll
    for (int o = 1; o < 64; o <<= 1) v += __shfl_xor(v, o);
    return v;
}

#define XB_TMO      128
#define XB_XCNT(j)  (256  + 64 * (j))
#define XB_XSUB(j)  (1280 + 64 * (j))
#define XB_XGEN(j)  (2304 + 64 * (j))
#define XB_TOP      3328
#define XB_TOPGEN   3392
#define XCD_BAR_WORDS 3456
#define XB_SPIN_CAP (1u << 18)

__device__ __forceinline__ unsigned xb_ld(unsigned* p)              { return __hip_atomic_load(p, __ATOMIC_RELAXED, __HIP_MEMORY_SCOPE_AGENT); }
__device__ __forceinline__ unsigned xb_add(unsigned* p, unsigned v) { return __hip_atomic_fetch_add(p, v, __ATOMIC_RELAXED, __HIP_MEMORY_SCOPE_AGENT); }
__device__ __forceinline__ unsigned xb_xcc_id() { return (unsigned)__builtin_amdgcn_s_getreg((3 << 11) | 20) & 0xFu; }
#define XB_SPIN(cond, bar) do { unsigned _sp = 0; while (cond) { __builtin_amdgcn_s_sleep(1); \
    if ((++_sp & 255u) == 0u) { if (xb_ld(&(bar)[XB_TMO])) break; if (_sp > XB_SPIN_CAP) { atomicAdd(&(bar)[XB_TMO], 1u); break; } } } } while (0)

struct XcdBarrier {
    unsigned* bar; unsigned x;
    volatile LAS unsigned* st;
};

__device__ __forceinline__ XcdBarrier xcd_barrier_post(unsigned* bar, volatile LAS unsigned* st) {
    XcdBarrier b; b.bar = bar; b.x = xb_xcc_id(); b.st = st;
    if (threadIdx.x == 0) (void)xb_add(&bar[XB_XCNT(b.x)], 1u);
    return b;
}
__device__ __forceinline__ void xcd_barrier_complete(unsigned* bar, unsigned x, unsigned& nloc, unsigned& nx) {
    const unsigned G = gridDim.x * gridDim.y * gridDim.z;
    unsigned sum, cnt, mine, sp = 0u;
    for (;;) {
        sum = 0u; cnt = 0u; mine = 0u;
#pragma unroll
        for (unsigned j = 0; j < 16; ++j) { const unsigned c = xb_ld(&bar[XB_XCNT(j)]); sum += c; cnt += (c > 0u) ? 1u : 0u; mine = (j == x) ? c : mine; }
        if (sum == G) break;
        __builtin_amdgcn_s_sleep(1);
        if ((++sp & 255u) == 0u) { if (xb_ld(&bar[XB_TMO])) break; if (sp > XB_SPIN_CAP) { atomicAdd(&bar[XB_TMO], 1u); break; } }
    }
    nloc = mine > 0u ? mine : 1u; nx = cnt > 0u ? cnt : 1u;
}

__device__ __forceinline__ void xcd_barrier(const XcdBarrier& b) {
    asm volatile("s_waitcnt vmcnt(0)" ::: "memory");
    __syncthreads();
    if (threadIdx.x == 0) {
        unsigned* bar = b.bar;
        __builtin_amdgcn_s_waitcnt(0);
        unsigned nloc = b.st[0], nx = b.st[1];
        if (nloc == 0u) { xcd_barrier_complete(bar, b.x, nloc, nx); b.st[0] = nloc; b.st[1] = nx; }
        const unsigned old = xb_add(&bar[XB_XSUB(b.x)], 1u);
        const unsigned gen = old / nloc;
        if (old + 1u == (gen + 1u) * nloc) {
            __builtin_amdgcn_fence(__ATOMIC_RELEASE, "agent");
            asm volatile("s_waitcnt vmcnt(0)" ::: "memory");
            const unsigned og = xb_add(&bar[XB_TOP], 1u);
            const unsigned tg = og / nx;
            if (og + 1u == (tg + 1u) * nx) xb_add(&bar[XB_TOPGEN], 1u);
            else XB_SPIN(xb_ld(&bar[XB_TOPGEN]) == tg, bar);
            __builtin_amdgcn_fence(__ATOMIC_ACQUIRE, "agent");
            xb_add(&bar[XB_XGEN(b.x)], 1u);
            asm volatile("s_waitcnt vmcnt(0)" ::: "memory");
        } else {
            XB_SPIN(xb_ld(&bar[XB_XGEN(b.x)]) == gen, bar);
            __builtin_amdgcn_fence(__ATOMIC_ACQUIRE, "agent");
            asm volatile("s_waitcnt vmcnt(0)" ::: "memory");
        }
    }
    __syncthreads();
}


constexpr int TR_SCR = 16896;
template <bool FP8 = false> __device__ __forceinline__ void transpose_item(const float* W, int K, int N, bf16* WT, int ldt, int mode, LAS float* scr, int item, int lane, float mul = 1.f, const float* rg = nullptr) {
    const int nblk = N / 64, kb = item / nblk, nb = item % nblk, k0 = 64 * kb, n0 = 64 * nb;
    const int vrow0 = mode == 0 ? n0 : ((n0 >> 7) * 256 + (n0 & 127) + (mode == 2 ? 128 : 0));
    const int kr = lane >> 4, nq = (lane & 15) * 4;
    f32x4 v[16];
#pragma unroll
    for (int i = 0; i < 16; ++i) v[i] = *(const GAS f32x4*)(W + (size_t)(k0 + 4 * i + kr) * N + n0 + nq);
    if (rg) {
#pragma unroll
        for (int i = 0; i < 16; ++i) v[i] *= rg[k0 + 4 * i + kr]; }
#pragma unroll
    for (int i = 0; i < 16; ++i) { LAS float* d = scr + (4 * i + kr) * 65 + nq; d[0] = v[i].x; d[1] = v[i].y; d[2] = v[i].z; d[3] = v[i].w; }
    LDS_WAIT(); asm volatile("" ::: "memory");
    const int c = lane & 7;
#pragma unroll
    for (int j = 0; j < 8; ++j) { const int n = (lane >> 3) + 8 * j; const LAS float* s = scr + (8 * c) * 65 + n;
        if constexpr (FP8) { v2u o; o.x = pg8::pk4_fp8(mul * s[0 * 65], mul * s[1 * 65], mul * s[2 * 65], mul * s[3 * 65]); o.y = pg8::pk4_fp8(mul * s[4 * 65], mul * s[5 * 65], mul * s[6 * 65], mul * s[7 * 65]);
            *(GAS v2u*)((unsigned char*)WT + (size_t)(vrow0 + n) * ldt + k0 + 8 * c) = o; }
        else { v4u o; o.x = pk2(s[0 * 65], s[1 * 65]); o.y = pk2(s[2 * 65], s[3 * 65]); o.z = pk2(s[4 * 65], s[5 * 65]); o.w = pk2(s[6 * 65], s[7 * 65]);
            *(GAS v4u*)(WT + (size_t)(vrow0 + n) * ldt + k0 + 8 * c) = o; } }
    LDS_WAIT(); asm volatile("" ::: "memory");
}
__device__ __forceinline__ void cvt_small_weights(const float* w_in, const float* norm_mix, const float* w_bd, const float* w_bw, const float* w_out, unsigned char* ws, LAS float* scr, int gw, int ngw, int lane) {
    constexpr int I_IN = 16 * 68, I_B = 8 * 16, I_O = 16 * 16, I_L = I_IN + 2 * I_B + I_O;
    for (int it = gw; it < 2 * I_L; it += ngw) {
        const int l = it / I_L; int r = it % I_L;
        if (r < I_IN) { if (r % 68 < 36) transpose_item(w_in + (size_t)l * DM * INC, DM, INC, (bf16*)(ws + WS_WIN) + (size_t)l * INC * DM, DM, 0, scr, r, lane, 1.f, norm_mix + l * DM);
            else transpose_item<true>(w_in + (size_t)l * DM * INC, DM, INC, (bf16*)(ws + WS_WG8 + (size_t)l * GATEC * DM - (size_t)QKVC * DM), DM, 0, scr, r, lane, pg8::WGU8_MUL, norm_mix + l * DM);
            continue; } r -= I_IN;
        if (r < I_B) { transpose_item<true>(w_bd + (size_t)l * 512 * DM, 512, DM, (bf16*)(ws + WS_PT + (size_t)l * DM * DM), DM, 0, scr, r, lane, pg8::PT8_MUL); continue; } r -= I_B;
        if (r < I_B) { transpose_item<true>(w_bw + (size_t)l * 512 * DM, 512, DM, (bf16*)(ws + WS_PT + (size_t)l * DM * DM + 512), DM, 0, scr, r, lane, pg8::PT8_MUL); continue; } r -= I_B;
        transpose_item<true>(w_out + (size_t)l * DM * DM, DM, DM, (bf16*)(ws + WS_WO + (size_t)l * DM * DM), DM, 0, scr, r, lane, pg8::WO8_MUL);
    }
}
__device__ __forceinline__ void cvt_expert_item(const float* wg, const float* wu, const float* wd, int l, unsigned char* wgu, unsigned char* wdn, LAS float* scr, int it, int lane) {
    const int e = it / 384, r = it % 384, which = r >> 7, item = r & 127;
    const size_t eo = (size_t)(l * NEXP + e) * DM * FH;
    if (which == 0) transpose_item<true>(wg + eo, DM, FH, (bf16*)(wgu + (size_t)e * 1024 * DM), DM, 1, scr, item, lane, pg8::WGU8_MUL);
    else if (which == 1) transpose_item<true>(wu + eo, DM, FH, (bf16*)(wgu + (size_t)e * 1024 * DM), DM, 2, scr, item, lane, pg8::WGU8_MUL);
    else transpose_item<true>(wd + eo, FH, DM, (bf16*)(wdn + (size_t)e * DM * FH), FH, 0, scr, item, lane, pg8::WD8_MUL);
}
__device__ __forceinline__ void cvt_expert_weights(const float* wg, const float* wu, const float* wd, int l, unsigned char* ws, LAS float* scr, int gw, int ngw, int lane) {
    for (int it = gw; it < NEXP * 384; it += ngw) cvt_expert_item(wg, wu, wd, l, ws + WS_WGU, ws + WS_WD, scr, it, lane);
}
__device__ __forceinline__ void cvt_fill_slots(const float* wg, const float* wu, const float* wd, unsigned char* ws, LAS float* scr, int base, int kstride, int slot, int budget, int lane) {
    for (int k = 0; k < budget; ++k) { const int it = base + k * kstride + slot; if (it < NEXP * 384) cvt_expert_item(wg, wu, wd, 1, ws + WS_WGU1, ws + WS_WD1, scr, it, lane); }
}
__device__ __forceinline__ void cvt_drain(const float* wg, const float* wu, const float* wd, unsigned char* ws, LAS float* scr, int G, int nun, int gw, int ngw, int lane) {
    const int r = nun % G, nshort = r ? G - r : 0, nhole = (G - nshort) * 8;
    const int base6 = FILL_P1 * (G / 2) * 8, base7 = base6 + FILL_P6 * G * 8, base8 = base7 + FILL_P7 * G * 8;
    for (int h = gw; h < FILL_P6 * nhole; h += ngw) { const int it = base6 + (h / nhole) * G * 8 + nshort * 8 + h % nhole; if (it < NEXP * 384) cvt_expert_item(wg, wu, wd, 1, ws + WS_WGU1, ws + WS_WD1, scr, it, lane); }
    for (int h = gw; h < FILL_P7 * nhole; h += ngw) { const int it = base7 + (h / nhole) * G * 8 + nshort * 8 + h % nhole; if (it < NEXP * 384) cvt_expert_item(wg, wu, wd, 1, ws + WS_WGU1, ws + WS_WD1, scr, it, lane); }
    for (int it = base8 + gw; it < NEXP * 384; it += ngw) cvt_expert_item(wg, wu, wd, 1, ws + WS_WGU1, ws + WS_WD1, scr, it, lane);
}
__device__ __forceinline__ void rms_row_to_bf16(const float* xrow, const float* gain, bf16* orow, bf16* xbrow, unsigned char* o8row, int lane) {
    const GAS f32x4* xr = (const GAS f32x4*)xrow + lane; const GAS f32x4* gr = (const GAS f32x4*)gain + lane;
    f32x4 v[4]; float s = 0.f;
#pragma unroll
    for (int j = 0; j < 4; ++j) { v[j] = xr[64 * j]; s += (v[j].x * v[j].x + v[j].y * v[j].y) + (v[j].z * v[j].z + v[j].w * v[j].w); }
    const float rs = rsqrtf(wave_sum(s) * (1.f / DM) + RMS_EPS);
    GAS v2u* o8 = (GAS v2u*)orow + lane; GAS v2u* x8 = (GAS v2u*)xbrow + lane;
#pragma unroll
    for (int j = 0; j < 4; ++j) { v2u xw; xw.x = pk2(v[j].x, v[j].y); xw.y = pk2(v[j].z, v[j].w); x8[64 * j] = xw; }
#pragma unroll
    for (int j = 0; j < 4; ++j) { const f32x4 g = gr[64 * j]; const f32x4 hv = {v[j].x * rs * g.x, v[j].y * rs * g.y, v[j].z * rs * g.z, v[j].w * rs * g.w}; v2u w; w.x = pk2(hv.x, hv.y); w.y = pk2(hv.z, hv.w); o8[64 * j] = w;
        ((GAS unsigned*)o8row)[lane + 64 * j] = pg8::pk4_fp8(pg8::X8_MUL * hv.x, pg8::X8_MUL * hv.y, pg8::X8_MUL * hv.z, pg8::X8_MUL * hv.w); }
}

__device__ __forceinline__ void rms_rows4(const float* x, bf16* xb, unsigned char* x8p, float* rsout, int m0, int step, int lane) {
    f32x4 v[4][4]; float s[4];
#pragma unroll
    for (int u = 0; u < 4; ++u) { const int m = m0 + u * step; s[u] = 0.f; if (m < NTOK) { const GAS f32x4* xr = (const GAS f32x4*)(x + (size_t)m * DM) + lane;
#pragma unroll
        for (int j = 0; j < 4; ++j) v[u][j] = xr[64 * j]; } }
#pragma unroll
    for (int u = 0; u < 4; ++u) { const int m = m0 + u * step; if (m < NTOK) {
#pragma unroll
        for (int j = 0; j < 4; ++j) s[u] += (v[u][j].x * v[u][j].x + v[u][j].y * v[u][j].y) + (v[u][j].z * v[u][j].z + v[u][j].w * v[u][j].w);
        const float rs = rsqrtf(wave_sum(s[u]) * (1.f / DM) + RMS_EPS);
        if (lane == 0) rsout[m] = rs;
        GAS v2u* x8 = (GAS v2u*)(xb + (size_t)m * DM) + lane; GAS unsigned* q8 = (GAS unsigned*)(x8p + (size_t)m * DM) + lane;
#pragma unroll
        for (int j = 0; j < 4; ++j) { const f32x4 xv = v[u][j]; v2u xw; xw.x = pk2(xv.x, xv.y); xw.y = pk2(xv.z, xv.w); x8[64 * j] = xw;
            q8[64 * j] = pg8::pk4_fp8(pg8::X8_MUL * xv.x, pg8::X8_MUL * xv.y, pg8::X8_MUL * xv.z, pg8::X8_MUL * xv.w); } } }
}

constexpr int RA_PITCH = 2064, RA_HI = 0, RA_LO = 32 * RA_PITCH, RA_RED = 2 * 32 * RA_PITCH, RT_REC = RA_RED + 8192, RT_CNT = RT_REC + 2048, RT_BASE = RT_CNT + 128;
typedef short rbf16x8 __attribute__((ext_vector_type(8)));
typedef float rf32x16 __attribute__((ext_vector_type(16)));
template <int CTRL> __device__ __forceinline__ float dppf(float v) { return __uint_as_float((unsigned)__builtin_amdgcn_update_dpp(0, (int)__float_as_uint(v), CTRL, 0xf, 0xf, false)); }
__device__ __forceinline__ float rlane(float v, int l) { return __uint_as_float((unsigned)__builtin_amdgcn_readlane((int)__float_as_uint(v), l)); }
__device__ __forceinline__ void router_phase(LAS unsigned char* lds, const bf16* x, const float* gain, const bf16* rtw, const float* b_rg, const float* b_re,
                                             unsigned char* h2, unsigned* gcnt, unsigned* tokinfo, unsigned* elist, int blk, int G, int tid, int lane, int wave) {
    LAS float* part = (LAS float*)(lds + RA_HI);
    LAS unsigned* rec = (LAS unsigned*)(lds + RT_REC); LAS unsigned* cntL = (LAS unsigned*)(lds + RT_CNT); LAS unsigned* baseL = (LAS unsigned*)(lds + RT_BASE);
    const int r32 = lane & 31, hi = lane >> 5;
    rbf16x8 bh[8][2], bl[8][2];
#pragma unroll
    for (int ks = 0; ks < 8; ++ks)
#pragma unroll
        for (int cb = 0; cb < 2; ++cb) { const GAS rbf16x8* p = (const GAS rbf16x8*)(rtw + (size_t)(cb * 32 + r32) * DM + wave * 128 + ks * 16 + hi * 8); bh[ks][cb] = p[0]; bl[ks][cb] = p[64 * DM / 8]; }
    float bias = 0.f; if (lane < 4) bias = b_rg[lane]; else if (lane < 36) bias = b_re[lane - 4];
    f32x4 gq[4];
#pragma unroll
    for (int j = 0; j < 4; ++j) gq[j] = ((const GAS f32x4*)gain)[lane + 64 * j];
    for (int chunk = blk; chunk < NTOK / 128; chunk += G) {
        if (tid < 32) cntL[tid] = 0u;
        __syncthreads();
        const int tok0 = chunk * 128;
#pragma unroll 1
        for (int sub = 0; sub < 4; ++sub) {
            const int t0 = tok0 + sub * 32 + wave * 4;
#pragma unroll
            for (int r = 0; r < 4; ++r) {
                const GAS v2u* xr = (const GAS v2u*)(x + (size_t)(t0 + r) * DM) + lane; f32x4 v[4]; float s = 0.f;
#pragma unroll
                for (int j = 0; j < 4; ++j) { const v2u xw = xr[64 * j]; v[j] = (f32x4){bflo(xw.x), bfhi(xw.x), bflo(xw.y), bfhi(xw.y)}; s += (v[j].x * v[j].x + v[j].y * v[j].y) + (v[j].z * v[j].z + v[j].w * v[j].w); }
                const float rs = rsqrtf(wave_sum(s) * (1.f / DM) + RMS_EPS);
                GAS unsigned* o4 = (GAS unsigned*)(h2 + (size_t)(t0 + r) * DM) + lane;
                LAS unsigned char* arow = lds + (wave * 4 + r) * RA_PITCH + lane * 8;
#pragma unroll
                for (int j = 0; j < 4; ++j) { const f32x4 xn = v[j] * rs * gq[j];
                    const unsigned h0 = f2bf(xn.x), h1 = f2bf(xn.y), h2_ = f2bf(xn.z), h3 = f2bf(xn.w);
                    v2u wh; wh.x = h0 | (h1 << 16); wh.y = h2_ | (h3 << 16); o4[64 * j] = pg8::pk4_fp8(pg8::X8_MUL * xn.x, pg8::X8_MUL * xn.y, pg8::X8_MUL * xn.z, pg8::X8_MUL * xn.w);
                    v2u wl; wl.x = pk2(xn.x - __uint_as_float(h0 << 16), xn.y - __uint_as_float(h1 << 16)); wl.y = pk2(xn.z - __uint_as_float(h2_ << 16), xn.w - __uint_as_float(h3 << 16));
                    *(LAS v2u*)(arow + RA_HI + j * 512) = wh; *(LAS v2u*)(arow + RA_LO + j * 512) = wl; }
            }
            __syncthreads();
            rf32x16 acc0 = {}, acc1 = {};
            { const LAS unsigned char* ap = lds + r32 * RA_PITCH + (wave * 128 + hi * 8) * 2;
#pragma unroll
              for (int ks = 0; ks < 8; ++ks) { const rbf16x8 ah = *(const LAS rbf16x8*)(ap + RA_HI + ks * 32), al = *(const LAS rbf16x8*)(ap + RA_LO + ks * 32);
                acc0 = __builtin_amdgcn_mfma_f32_32x32x16_bf16(ah, bh[ks][0], acc0, 0, 0, 0); acc1 = __builtin_amdgcn_mfma_f32_32x32x16_bf16(ah, bh[ks][1], acc1, 0, 0, 0);
                acc0 = __builtin_amdgcn_mfma_f32_32x32x16_bf16(al, bh[ks][0], acc0, 0, 0, 0); acc1 = __builtin_amdgcn_mfma_f32_32x32x16_bf16(al, bh[ks][1], acc1, 0, 0, 0);
                acc0 = __builtin_amdgcn_mfma_f32_32x32x16_bf16(ah, bl[ks][0], acc0, 0, 0, 0); acc1 = __builtin_amdgcn_mfma_f32_32x32x16_bf16(ah, bl[ks][1], acc1, 0, 0, 0); } }
            __syncthreads();
#pragma unroll
            for (int rg = 0; rg < 16; ++rg) { const int row = (rg & 3) + 8 * (rg >> 2) + 4 * hi;
                part[(wave * 32 + row) * 40 + r32] = acc0[rg];
                if (r32 < 4) part[(wave * 32 + row) * 40 + 32 + r32] = acc1[rg]; }
            __syncthreads();
#pragma unroll
            for (int r = 0; r < 4; ++r) {
                float lsum = 0.f;
                if (lane < 36) {
#pragma unroll
                    for (int w = 0; w < 8; ++w) lsum += part[(w * 32 + wave * 4 + r) * 40 + lane]; }
                const float lv = lsum + bias;
                const float g0 = rlane(lv, 0), g1 = rlane(lv, 1), g2 = rlane(lv, 2), g3 = rlane(lv, 3);
                int gs = 0; float gm = g0; if (g1 > gm) { gm = g1; gs = 1; } if (g2 > gm) { gm = g2; gs = 2; } if (g3 > gm) { gm = g3; gs = 3; }
                const float gw = 1.0f / (__expf(g0 - gm) + __expf(g1 - gm) + __expf(g2 - gm) + __expf(g3 - gm));
                gs = __builtin_amdgcn_readfirstlane(gs);
                float ev[8];
#pragma unroll
                for (int i = 0; i < 8; ++i) ev[i] = rlane(lv, 4 + gs * 8 + i);
                int i1 = 0; float v1 = ev[0];
#pragma unroll
                for (int i = 1; i < 8; ++i) if (ev[i] > v1) { v1 = ev[i]; i1 = i; }
                int i2 = -1; float v2 = -3.0e38f;
#pragma unroll
                for (int i = 0; i < 8; ++i) if (i != i1 && ev[i] > v2) { v2 = ev[i]; i2 = i; }
                const float e21 = __expf(v2 - v1), inv = 1.0f / (1.0f + e21);
                const float wa = gw * inv, wb = gw * e21 * inv;
                if (lane == 0) {
                    const int e1 = gs * 8 + i1, e2 = gs * 8 + i2;
                    const unsigned p1 = __hip_atomic_fetch_add(&cntL[e1], 1u, __ATOMIC_RELAXED, __HIP_MEMORY_SCOPE_WORKGROUP), p2 = __hip_atomic_fetch_add(&cntL[e2], 1u, __ATOMIC_RELAXED, __HIP_MEMORY_SCOPE_WORKGROUP);
                    LAS unsigned* rp = rec + (t0 + r - tok0) * 4;
                    rp[0] = (unsigned)e1 | ((unsigned)e2 << 8); rp[1] = p1 | (p2 << 16); rp[2] = __float_as_uint(wa); rp[3] = __float_as_uint(wb);
                }
            }
            __syncthreads();
        }
        if (tid < 32) baseL[tid] = __hip_atomic_fetch_add(gcnt + tid, cntL[tid], RLX_AGENT);
        __syncthreads();
        if (tid < 128) {
            const unsigned ee = rec[tid * 4 + 0], pp = rec[tid * 4 + 1]; const unsigned e1 = ee & 255u, e2 = ee >> 8;
            v4u a; a.x = e1; a.y = baseL[e1] + (pp & 0xffffu); a.z = e2; a.w = baseL[e2] + (pp >> 16);
            v4u b; b.x = rec[tid * 4 + 2]; b.y = rec[tid * 4 + 3]; b.z = 0u; b.w = 0u;
            GAS v4u* ti = (GAS v4u*)(tokinfo + (size_t)(tok0 + tid) * 8); ti[0] = a; ti[1] = b;
            elist[(size_t)e1 * NTOK + a.y] = (unsigned)(tok0 + tid); elist[(size_t)e2 * NTOK + a.w] = (unsigned)(tok0 + tid);
        }
        __syncthreads();
    }
}
__device__ __forceinline__ void cvt_router_weights(const float* w_rg, const float* w_re, bf16* rtw, int gtid, int nthr) {
    for (int idx = gtid; idx < DEPTH * 64 * DM; idx += nthr) { const int l = idx >> 16, col = (idx >> 10) & 63, k = idx & 1023;
        const float v = col < 4 ? w_rg[((size_t)l * DM + k) * 4 + col] : (col < 36 ? w_re[((size_t)l * DM + k) * 32 + col - 4] : 0.f);
        const unsigned hb = f2bf(v); const float lo = v - __uint_as_float(hb << 16);
        rtw[(size_t)l * 2 * 64 * DM + (size_t)col * DM + k] = (bf16)hb; rtw[(size_t)l * 2 * 64 * DM + 64 * DM + (size_t)col * DM + k] = (bf16)f2bf(lo); }
}
__device__ __forceinline__ void moe_tables(volatile LAS unsigned* MISC, const unsigned* gcnt, int tid) {
    if (tid == 0) {
        unsigned ps = 0, T = 0;
        for (int e = 0; e < NEXP; ++e) { const unsigned cnt = __hip_atomic_load(gcnt + e, RLX_AGENT); const unsigned nt = (cnt + 255u) >> 8;
            MISC[MW_PAD + e] = ps; MISC[MW_CNT + e] = cnt; for (unsigned k = 0; k < nt && T < (unsigned)RMAX_TILES; ++k) MISC[MW_TILE + (T++)] = (unsigned)e; ps += nt * 256u; }
        MISC[MW_PAD + NEXP] = ps; MISC[MW_NT] = T;
    }
    __syncthreads();
}
__device__ __forceinline__ void moe_rowtab(volatile LAS unsigned* MISC, const unsigned* elist, int blk, int G, int tid) {
    const int nunits = (int)MISC[MW_NT] * 4;
    for (int ui = 0; ui < ROWTAB_UNITS; ++ui) { const int Lu = ui * G + blk; if (Lu >= nunits) break;
        const int pm = pg8::MoeOrder::unit_of(Lu, nunits) >> 2; const unsigned e = MISC[MW_TILE + pm];
        if (tid < 256) { const unsigned slot = (unsigned)(pm * 256 + tid) - MISC[MW_PAD + e]; MISC[MW_ROW + ui * 256 + tid] = slot < MISC[MW_CNT + e] ? elist[(size_t)e * NTOK + slot] : 0u; } }
    __syncthreads();
}
template <bool LAST> __device__ __forceinline__ void combine_phase(volatile LAS unsigned* MISC, const bf16* xin, bf16* xout, float* fout, const unsigned char* ys, const unsigned* tokinfo, const float* gain, float* rsout, unsigned char* hn8, int gw, int ngw, int lane) {
    f32x4 gq[4];
#pragma unroll
    for (int j = 0; j < 4; ++j) gq[j] = LAST ? ((const GAS f32x4*)gain)[lane + 64 * j] : (f32x4){0.f, 0.f, 0.f, 0.f};
    v4u ra[2], rb[2];
#pragma unroll
    for (int u = 0; u < 2; ++u) { const int tok = gw + u * ngw; ra[u] = (v4u){0u, 0u, 0u, 0u}; rb[u] = ra[u]; if (tok < NTOK) { const GAS v4u* ti = (const GAS v4u*)(tokinfo + (size_t)tok * 8); ra[u] = ti[0]; rb[u] = ti[1]; } }
    for (int tok0 = gw; tok0 < NTOK; tok0 += 2 * ngw) {
        f32x4 v[2][4]; unsigned p[2][4], q[2][4]; float w1[2], w2[2];
        v4u ca[2], cb[2];
#pragma unroll
        for (int u = 0; u < 2; ++u) { ca[u] = ra[u]; cb[u] = rb[u]; const int tokn = tok0 + (2 + u) * ngw; if (tokn < NTOK) { const GAS v4u* tn = (const GAS v4u*)(tokinfo + (size_t)tokn * 8); ra[u] = tn[0]; rb[u] = tn[1]; } }
#pragma unroll
        for (int u = 0; u < 2; ++u) { const int tok = tok0 + u * ngw; if (tok < NTOK) {
            const v4u a = ca[u], b = cb[u];
            const unsigned r1 = MISC[MW_PAD + a.x] + a.y, r2 = MISC[MW_PAD + a.z] + a.w; w1[u] = __uint_as_float(b.x) * (1.0f / pg8::YS8_MUL); w2[u] = __uint_as_float(b.y) * (1.0f / pg8::YS8_MUL);
            const GAS v2u* xi = (const GAS v2u*)(xin + (size_t)tok * DM) + lane;
            const GAS unsigned* y1 = (const GAS unsigned*)(ys + (size_t)r1 * DM) + lane; const GAS unsigned* y2 = (const GAS unsigned*)(ys + (size_t)r2 * DM) + lane;
#pragma unroll
            for (int j = 0; j < 4; ++j) { const v2u xw = xi[64 * j]; v[u][j] = (f32x4){bflo(xw.x), bfhi(xw.x), bflo(xw.y), bfhi(xw.y)}; p[u][j] = y1[64 * j]; q[u][j] = y2[64 * j]; } } }
#pragma unroll
        for (int u = 0; u < 2; ++u) { const int tok = tok0 + u * ngw; if (tok < NTOK) {
            float s = 0.f;
#pragma unroll
            for (int j = 0; j < 4; ++j) { f32x4& x = v[u][j]; const f32x4 pp = fp8x4_to_f32(p[u][j]), qq = fp8x4_to_f32(q[u][j]);
                x += pp * w1[u] + qq * w2[u];
                s += (x.x * x.x + x.y * x.y) + (x.z * x.z + x.w * x.w); }
            const float rs = rsqrtf(wave_sum(s) * (1.f / DM) + RMS_EPS);
            if (LAST) {
                GAS f32x4* xr = (GAS f32x4*)(fout + (size_t)tok * DM) + lane;
#pragma unroll
                for (int j = 0; j < 4; ++j) xr[64 * j] = v[u][j] * rs * gq[j];
            } else {
                GAS v2u* x8 = (GAS v2u*)(xout + (size_t)tok * DM) + lane; if (lane == 0) rsout[tok] = rs;
#pragma unroll
                for (int j = 0; j < 4; ++j) { const f32x4 x = v[u][j]; v2u xw; xw.x = pk2(x.x, x.y); xw.y = pk2(x.z, x.w); x8[64 * j] = xw;
                    ((GAS unsigned*)(hn8 + (size_t)tok * DM))[lane + 64 * j] = pg8::pk4_fp8(pg8::X8_MUL * x.x, pg8::X8_MUL * x.y, pg8::X8_MUL * x.z, pg8::X8_MUL * x.w); }
            } } }
    }
}

struct Args { const float* in[19]; float* out; unsigned char* ws; };
__global__ void __launch_bounds__(NWAVES * 64, 2) fwd_kernel(Args args) {
    extern __shared__ __attribute__((aligned(16))) unsigned char lds[];
    LAS unsigned char* L = (LAS unsigned char*)lds;
    volatile LAS unsigned* MISC = (volatile LAS unsigned*)(L + LDS_MISC);
    int tid = threadIdx.x, lane = tid & 63, wave = __builtin_amdgcn_readfirstlane(tid >> 6);
    const int G = gridDim.x, blk = blockIdx.x;
    const int vcu = (G % 8 == 0) ? (blk % 8) * (G / 8) + blk / 8 : blk;
    int gw = vcu * NWAVES + wave; const int ngw = G * NWAVES;
#define RELANE() do { tid = threadIdx.x; asm volatile("" : "+v"(tid)); lane = tid & 63; wave = __builtin_amdgcn_readfirstlane(tid >> 6); gw = vcu * NWAVES + wave; scr = (LAS float*)(L + wave * TR_SCR); } while (0)
    unsigned char* ws = args.ws;
    unsigned* ctl = (unsigned*)(ws + WS_CTL);
    for (int u = tid; u < (LDS_BYTES - LDS_MISC) / 4; u += NWAVES * 64) MISC[u] = 0u;
    __syncthreads();
    XcdBarrier bar = xcd_barrier_post(ctl + CW_BAR, MISC);
#define GRID_BAR() do { unsigned x_ = bar.x; asm volatile("" : "+s"(x_)); bar.x = x_; xcd_barrier(bar); } while (0)
    const float* x_in = args.in[0];
    bf16* XB0 = (bf16*)args.out; bf16* XB1 = (bf16*)(ws + WS_O);
    bf16* Hb = (bf16*)(ws + WS_H); bf16* QKV = (bf16*)(ws + WS_QKV); bf16* GATES = (bf16*)(ws + WS_GATES); bf16* OB = (bf16*)(ws + WS_O);
    unsigned char* YS = (unsigned char*)QKV; bf16* HID = GATES; bf16* MERGED = Hb;
    unsigned* tokinfo = (unsigned*)(ws + WS_TOK); unsigned* elist = (unsigned*)(ws + WS_LIST);
    LAS float* scr = (LAS float*)(L + wave * TR_SCR);
    RELANE();

    for (int rep_ = 0; rep_ < REPS(0); ++rep_) {
    if (PH(0)) {
    cvt_small_weights(args.in[1], args.in[9], args.in[5], args.in[6], args.in[7], ws, scr, gw, ngw, lane);
    cvt_expert_weights(args.in[15], args.in[16], args.in[17], 0, ws, scr, gw, ngw, lane);
    cvt_router_weights(args.in[11], args.in[13], (bf16*)(ws + WS_RTW), vcu * (NWAVES * 64) + tid, G * NWAVES * 64);
    for (int m = gw; m < NTOK; m += 4 * ngw) rms_rows4(x_in, XB0, ws + WS_H8, (float*)(ws + WS_RS), m, ngw, lane);
    }
    GRID_BAR();
    }

#pragma unroll 1
    for (int l = 0; l < DEPTH; ++l) {
        for (int rep_ = 0; rep_ < REPS(1); ++rep_) {
        if (PH(1)) {
            { pg8::Gemm g{XB0, (const bf16*)(ws + WS_WIN) + (size_t)l * INC * DM, NTOK, INC, DM}; pg8::ColWindowOrder S; S.init(NTOK, QKVC, 0, G, blk);
              pg8::EpiInProj E{QKV, GATES, (const float*)(ws + WS_RS)};
              pg8::gemm_phase<pg8::EpiInProj, pg8::ColWindowOrder, true, true>(L, g, S, E); }
            { pg8::Gemm g{(const bf16*)(ws + WS_H8), (const bf16*)(ws + WS_WG8 + (size_t)l * GATEC * DM - (size_t)QKVC * DM), NTOK, INC, DM / 2}; pg8::LateOrder S; S.init(NTOK, GATEC, 9, G, blk);
              pg8::EpiInProj8 E{QKV, (unsigned char*)GATES, (const float*)(ws + WS_RS)};
              pg8::gemm_phase<pg8::EpiInProj8, pg8::LateOrder, true, true>(L, g, S, E); }
            if (FILL_P1 > 0 && l == 0 && blk < G / 2) { asm volatile("s_waitcnt vmcnt(0) lgkmcnt(0)" ::: "memory"); __syncthreads(); RELANE(); cvt_fill_slots(args.in[15], args.in[16], args.in[17], ws, scr, 0, (G / 2) * 8, blk * 8 + wave, FILL_P1, lane); }
        }
        GRID_BAR();
        }
        {
            const float lambda_init = 0.8f - 0.6f * __expf(-0.3f * (float)l);
            att::DiffParams dp{args.in[2] + l * 256, args.in[3] + l * 128, lambda_init};
            for (int rep_ = 0; rep_ < REPS(2); ++rep_) { if (PH(2))
            { int hp = -1; for (int u = vcu; u < NBATCH * 4 * 16; u += G) { const int bh = u >> 4, qb = u & 15; att::attn_unit<true>((char*)lds, QKV, OB, bh >> 2, bh & 3, qb * 128, args.in[8], nullptr, dp, (bh & 3) != hp); hp = bh & 3; } }
            if (rep_ + 1 < REPS(2)) GRID_BAR(); }
            for (int rep_ = 0; rep_ < REPS(10); ++rep_) { if (PH(2))
            { int hp = -1; for (int u = vcu; u < NBATCH * 2 * 16; u += G) { const int bh = u >> 4, qb = u & 15; att::attn_unit_win2((char*)lds, QKV, OB, bh >> 1, bh & 1, qb * 128, args.in[8], args.in[4] + l * 8, (bh & 1) != hp); hp = bh & 1; } }
            if (rep_ + 1 < REPS(10)) GRID_BAR(); }
        }
        GRID_BAR();
        for (int rep_ = 0; rep_ < REPS(3); ++rep_) {
        if (PH(3)) {
            pg8::Gemm g{OB, (const bf16*)(ws + WS_PT + (size_t)l * DM * DM), NTOK, DM, DM / 2}; pg8::StaticOrder S; S.init(NTOK, DM, G, blk);
            pg8::EpiMergeF8 E{(const unsigned char*)GATES, (unsigned char*)MERGED};
            pg8::gemm_phase<pg8::EpiMergeF8, pg8::StaticOrder, true, true>(L, g, S, E);
        }
        GRID_BAR();
        }
        for (int rep_ = 0; rep_ < (l == 0 ? REPS(4) : 1); ++rep_) {
        if (PH(4)) {
            pg8::Gemm g{MERGED, (const bf16*)(ws + WS_WO + (size_t)l * DM * DM), NTOK, DM, DM / 2}; pg8::StaticOrder S; S.init(NTOK, DM, G, blk);
            pg8::EpiResid8 E{XB0, l + 1 < DEPTH ? XB0 : XB1};
            pg8::gemm_phase<pg8::EpiResid8, pg8::StaticOrder, true, true>(L, g, S, E);
        }
        GRID_BAR();
        }
        RELANE();
        if (PH(5)) router_phase(L, l + 1 < DEPTH ? XB0 : XB1, args.in[10] + l * DM, (const bf16*)(ws + WS_RTW) + (size_t)l * 2 * 64 * DM, args.in[12] + l * 4, args.in[14] + l * 32,
                     (unsigned char*)Hb, ctl + CW_CNT + 64 * l, tokinfo, elist, blk, G, tid, lane, wave);
        GRID_BAR();
        RELANE();
        moe_tables(MISC, ctl + CW_CNT + 64 * l, tid);
        moe_rowtab(MISC, elist, blk, G, tid);
        for (int rep_ = 0; rep_ < REPS(7); ++rep_) {
        if (PH(7)) {
            const int ntile = __builtin_amdgcn_readfirstlane((int)MISC[MW_NT]);
            pg8::Gemm g{Hb, (const bf16*)(ws + (l == 0 ? WS_WGU : WS_WGU1)), ntile * 256, 1024, DM / 2}; pg8::MoeOrder S{ntile * 4, G, blk, (const LAS int*)(L + LDS_MISC) + MW_TILE, (const LAS int*)(L + LDS_MISC) + MW_ROW};
            pg8::EpiSwiGlu8 E{(unsigned char*)HID};
            pg8::gemm_phase_gather<pg8::EpiSwiGlu8, pg8::MoeOrder, true, true>(L, g, S, E);
            if (FILL_P6 > 0 && l == 0) { const int nun = ntile * 4, my = blk < nun ? (nun - 1 - blk) / G + 1 : 0; if (my < (nun + G - 1) / G) { asm volatile("s_waitcnt vmcnt(0) lgkmcnt(0)" ::: "memory"); __syncthreads(); RELANE(); cvt_fill_slots(args.in[15], args.in[16], args.in[17], ws, scr, FILL_P1 * (G / 2) * 8, G * 8, (blk - nun % G) * 8 + wave, FILL_P6, lane); } }
        }
        GRID_BAR();
        }
        for (int rep_ = 0; rep_ < REPS(8); ++rep_) {
        if (PH(8)) {
            const int ntile = __builtin_amdgcn_readfirstlane((int)MISC[MW_NT]);
            pg8::Gemm g{HID, (const bf16*)(ws + (l == 0 ? WS_WD : WS_WD1)), ntile * 256, 1024, FH / 2}; pg8::MoeOrder S{ntile * 4, G, blk, (const LAS int*)(L + LDS_MISC) + MW_TILE, nullptr};
            pg8::EpiDown8 E{YS};
            pg8::gemm_phase<pg8::EpiDown8, pg8::MoeOrder, true, true>(L, g, S, E);
            if (FILL_P7 > 0 && l == 0) { const int nun = ntile * 4, my = blk < nun ? (nun - 1 - blk) / G + 1 : 0; if (my < (nun + G - 1) / G) { asm volatile("s_waitcnt vmcnt(0) lgkmcnt(0)" ::: "memory"); __syncthreads(); RELANE(); cvt_fill_slots(args.in[15], args.in[16], args.in[17], ws, scr, FILL_P1 * (G / 2) * 8 + FILL_P6 * G * 8, G * 8, (blk - nun % G) * 8 + wave, FILL_P7, lane); } }
        }
        GRID_BAR();
        }
        RELANE();
        if (!PH(9)) {} else if (l + 1 < DEPTH) {
            combine_phase<false>(MISC, XB0, XB0, nullptr, YS, tokinfo, nullptr, (float*)(ws + WS_RS), ws + WS_H8, gw, ngw, lane);
{ const int ntile = __builtin_amdgcn_readfirstlane((int)MISC[MW_NT]); cvt_drain(args.in[15], args.in[16], args.in[17], ws, scr, G, ntile * 4, gw, ngw, lane); }
            GRID_BAR();
        } else {
            combine_phase<true>(MISC, XB1, nullptr, args.out, YS, tokinfo, args.in[18], nullptr, nullptr, gw, ngw, lane);
        }
    }
}

extern "C" void kernel_launch(void* const* d_in, const int* in_sizes, int n_in, void* d_out, int out_size, void* d_ws, size_t ws_size, hipStream_t stream) {
    static int grid = 0;
    if (grid == 0) {
        if (n_in != 19 || in_sizes[0] != NTOK * DM || out_size != NTOK * DM || ws_size < WS_END) {
            fprintf(stderr, "kernel_launch: built for 19 inputs, x/out of %d floats, >= %zu bytes of workspace; got n_in %d, in0 %d, out %d, ws %zu; nothing launched\n", NTOK * DM, (size_t)WS_END, n_in, n_in > 0 ? in_sizes[0] : -1, out_size, ws_size);
            grid = -1; return; }
        int dev = 0, cus = 0, per_cu = 0;
        if (hipGetDevice(&dev) != hipSuccess || hipDeviceGetAttribute(&cus, hipDeviceAttributeMultiprocessorCount, dev) != hipSuccess) { fprintf(stderr, "kernel_launch: device query failed\n"); grid = -1; return; }
        if (hipFuncSetAttribute((const void*)fwd_kernel, hipFuncAttributeMaxDynamicSharedMemorySize, LDS_BYTES) != hipSuccess) { fprintf(stderr, "kernel_launch: hipFuncSetAttribute failed\n"); grid = -1; return; }
        if (hipOccupancyMaxActiveBlocksPerMultiprocessor(&per_cu, (const void*)fwd_kernel, NWAVES * 64, LDS_BYTES) != hipSuccess || per_cu < 1)
            fprintf(stderr, "kernel_launch: note: occupancy query reports %d workgroups per CU\n", per_cu);
        (void)hipGetLastError();
        grid = cus;
    }
    if (grid < 0) return;
    if (hipMemsetAsync((char*)d_ws + WS_CTL, 0, CTL_ZERO_BYTES, stream) != hipSuccess) { fprintf(stderr, "kernel_launch: hipMemsetAsync failed\n"); return; }
    Args a{};
    for (int i = 0; i < 19; ++i) a.in[i] = (const float*)d_in[i];
    a.out = (float*)d_out; a.ws = (unsigned char*)d_ws;
    hipLaunchKernelGGL(fwd_kernel, dim3(grid), dim3(NWAVES * 64), LDS_BYTES, stream, a);
    const hipError_t le = hipPeekAtLastError();
    if (le != hipSuccess) fprintf(stderr, "kernel_launch: launch failed: %s\n", hipGetErrorName(le));
}
```

```cpp
#include <hip/hip_runtime.h>
#include <cstdio>
#include <cstdint>

namespace pg8 {
#define PG8_LAS __attribute__((address_space(3)))
typedef unsigned short bf16_t;
typedef short bf16x8 __attribute__((ext_vector_type(8)));
typedef float f32x4 __attribute__((ext_vector_type(4)));
typedef unsigned u32x4 __attribute__((ext_vector_type(4)));
constexpr int BM = 256, BK = 64, HALF = 128, HTB = HALF * BK * 2  , STAGE_BYTES = 8 * HTB, NXCD = 8, WGM = 8;

__host__ __device__ __forceinline__ int lds_byte(int r, int c) { const int st = (r >> 4) * 2 + (c >> 5), rr = r & 15, cc = c & 31, ob = rr * 64 + cc * 2; return st * 1024 + (ob ^ (((ob >> 9) & 1) << 5)); }
__host__ __device__ __forceinline__ void stage_rc(int b, int& R, int& C) { const int st = b / 1024, sb = b % 1024, swz = sb ^ (((sb >> 9) & 1) << 5); R = (st >> 1) * 16 + swz / 64; C = (st & 1) * 32 + (swz % 64) / 2; }
__host__ __device__ __forceinline__ int perm32(int rho) { const int n = rho >> 4, i = rho & 15; return 8 * (i >> 2) + 4 * n + (i & 3); }

struct Unit { int pm, pn; };
struct Gemm { const bf16_t* A; const bf16_t* Bt; int M, N, K; };

struct StaticOrder {
    int nM, nN, nwg, G, c;
    __host__ __device__ void init(int M, int N, int G_, int c_) { nM = M / BM; nN = N / BM; nwg = nM * nN; G = G_; c = c_; }
    __host__ __device__ bool from_slot(long L, Unit& u) const {
        if (L >= nwg) return false;
        int wgid = (int)L; { const int q = nwg / NXCD, r = nwg % NXCD, xcd = wgid % NXCD, off = wgid / NXCD; wgid = (xcd < r ? xcd * (q + 1) : r * (q + 1) + (xcd - r) * q) + off; }
        const int nig = WGM * nN, gid = wgid / nig, fm = gid * WGM, gsz = (nM - fm) < WGM ? (nM - fm) : WGM;
        u.pm = fm + ((wgid % nig) % gsz); u.pn = (wgid % nig) / gsz; return true;
    }
    __host__ __device__ bool next(int i, Unit& u) const { return from_slot((long)i * G + c, u); }
    __device__ __forceinline__ void a_ready(const Unit&) const {}
    __device__ __forceinline__ void done(const Unit&) const {}
};
__host__ __device__ __forceinline__ int nth_tile(unsigned mask, int n) { int t = 0;
#pragma unroll
    for (int i = 0; i < 17; ++i) { if ((mask >> i) & 1u) { if (n == 0) t = i; --n; } }
    return t; }
struct ColWindowOrder {
    StaticOrder b; unsigned tmask;
    __host__ __device__ void init(int M, int ncols, unsigned tmask_, int G_, int c_) { b.init(M, ncols, G_, c_); tmask = tmask_; }
    __host__ __device__ bool next(int i, Unit& u) const { if (!b.next(i, u)) return false; u.pn = nth_tile(tmask, u.pn); return true; }
    __device__ __forceinline__ void a_ready(const Unit&) const {}
    __device__ __forceinline__ void done(const Unit&) const {}
};
struct LateOrder {
    StaticOrder b; bool skew; unsigned tmask; int R;
    __host__ __device__ void init(int M, int N, unsigned tmask_, int G_, int c_) { b.init(M, N, G_, c_); tmask = tmask_; R = b.nwg / G_; skew = (b.nwg == R * G_) && (G_ % 2 == 0); }
    __host__ __device__ bool slot(int i, Unit& u) const {
        if (!skew) return b.next(i, u);
        const int hg = b.G / 2;
        if (i < R - 1) return b.from_slot((long)i * b.G + b.c, u);
        if (b.c < hg || i > R) return false;
        return b.from_slot((long)(R - 1) * b.G + (i - (R - 1)) * hg + (b.c - hg), u);
    }
    __host__ __device__ bool next(int i, Unit& u) const { if (!slot(i, u)) return false; u.pn = nth_tile(tmask, u.pn); return true; }
    __device__ __forceinline__ void a_ready(const Unit&) const {}
    __device__ __forceinline__ void done(const Unit&) const {}
};

__device__ __forceinline__ unsigned cvt_pk_bf16(float lo, float hi) { unsigned r; asm volatile("v_cvt_pk_bf16_f32 %0, %1, %2" : "=v"(r) : "v"(lo), "v"(hi)); return r; }

#ifndef EPI_TWICE_MASK
#define EPI_TWICE_MASK 0
#endif
typedef float f32x2 __attribute__((ext_vector_type(2)));
#define PG8_GAS __attribute__((address_space(1)))
__device__ __forceinline__ float bf_lo(unsigned w) { return __uint_as_float(w << 16); }
__device__ __forceinline__ float bf_hi(unsigned w) { return __uint_as_float(w & 0xffff0000u); }
__device__ __forceinline__ float sigmoid_f(float x) { return __builtin_amdgcn_rcpf(1.0f + __builtin_amdgcn_exp2f(-1.4426950408889634f * x)); }
__device__ __forceinline__ u32x4 pack8(const f32x4 v0, const f32x4 v1) { u32x4 w; w.x = cvt_pk_bf16(v0[0], v0[1]); w.y = cvt_pk_bf16(v0[2], v0[3]); w.z = cvt_pk_bf16(v1[0], v1[1]); w.w = cvt_pk_bf16(v1[2], v1[3]); return w; }

struct EpiInProj {
    static constexpr bool PERM = true, AFTER_DRAIN = false, HAS_MID = false, PROBE2 = (EPI_TWICE_MASK & 2) != 0, FP8 = false;
    bf16_t* qkv; bf16_t* gates; const float* rs;
    __device__ __forceinline__ void operator()(const f32x4 (&acc)[2][2][4][2], const Unit& u, int wr, int wc, int fr, int fq) const {
        const int row0 = u.pm * BM + wr * 64 + fr; int colt = u.pn * BM;
        const bool isg = colt >= 2304; bf16_t* base = isg ? gates : qkv; const int ldc = isg ? 2048 : 2304; if (isg) colt -= 2304;
        const int col0 = colt + wc * 32 + 8 * fq;
#pragma unroll
        for (int ai = 0; ai < 2; ++ai)
#pragma unroll
            for (int m = 0; m < 4; ++m) { bf16_t* rowp = base + (size_t)(row0 + ai * HALF + m * 16) * ldc + col0; const float rr = rs[row0 + ai * HALF + m * 16];
#pragma unroll
                for (int bj = 0; bj < 2; ++bj) { f32x4 v0 = acc[ai][bj][m][0] * rr, v1 = acc[ai][bj][m][1] * rr;
                    if (isg) {
#pragma unroll
                        for (int i = 0; i < 4; ++i) { v0[i] = sigmoid_f(v0[i]); v1[i] = sigmoid_f(v1[i]); } }
                    *(u32x4*)(rowp + bj * HALF) = pack8(v0, v1); } }
    }
};
struct EpiInProj8 {
    static constexpr bool PERM = true, AFTER_DRAIN = false, HAS_MID = false, PROBE2 = false, FP8 = true;
    static constexpr int SCALE_X = 125, SCALE_W = 122;
    bf16_t* qkv; unsigned char* gates; const float* rs;
    __device__ __forceinline__ void operator()(const f32x4 (&acc)[2][2][4][2], const Unit& u, int wr, int wc, int fr, int fq) const {
        const int row0 = u.pm * BM + wr * 64 + fr;
        if (u.pn < 9) {
            const int colq = u.pn * BM + wc * 32 + 8 * fq;
#pragma unroll
            for (int ai = 0; ai < 2; ++ai)
#pragma unroll
                for (int m = 0; m < 4; ++m) { bf16_t* rowp = qkv + (size_t)(row0 + ai * HALF + m * 16) * 2304 + colq; const float rr = rs[row0 + ai * HALF + m * 16];
#pragma unroll
                    for (int bj = 0; bj < 2; ++bj) *(u32x4*)(rowp + bj * HALF) = pack8(acc[ai][bj][m][0] * rr, acc[ai][bj][m][1] * rr); }
            return; }
        const int col0 = u.pn * BM - 2304 + wc * 32 + 8 * fq;
        typedef unsigned u32x2 __attribute__((ext_vector_type(2)));
#pragma unroll
        for (int ai = 0; ai < 2; ++ai)
#pragma unroll
            for (int m = 0; m < 4; ++m) { unsigned char* rowp = gates + (size_t)(row0 + ai * HALF + m * 16) * 2048 + col0; const float kk = rs[row0 + ai * HALF + m * 16] * -1.4426950408889634f;
#pragma unroll
                for (int bj = 0; bj < 2; ++bj) { const f32x4 a0 = acc[ai][bj][m][0], a1 = acc[ai][bj][m][1]; u32x2 o; o.x = 0u; o.y = 0u;
#define PG8_SG(x) __builtin_amdgcn_rcpf(__builtin_fmaf(__builtin_amdgcn_exp2f((x) * kk), 1.0f / 255.0f, 1.0f / 255.0f))
                    o.x = __builtin_amdgcn_cvt_pk_u8_f32(PG8_SG(a0[0]), 0, o.x); o.x = __builtin_amdgcn_cvt_pk_u8_f32(PG8_SG(a0[1]), 1, o.x);
                    o.x = __builtin_amdgcn_cvt_pk_u8_f32(PG8_SG(a0[2]), 2, o.x); o.x = __builtin_amdgcn_cvt_pk_u8_f32(PG8_SG(a0[3]), 3, o.x);
                    o.y = __builtin_amdgcn_cvt_pk_u8_f32(PG8_SG(a1[0]), 0, o.y); o.y = __builtin_amdgcn_cvt_pk_u8_f32(PG8_SG(a1[1]), 1, o.y);
                    o.y = __builtin_amdgcn_cvt_pk_u8_f32(PG8_SG(a1[2]), 2, o.y); o.y = __builtin_amdgcn_cvt_pk_u8_f32(PG8_SG(a1[3]), 3, o.y);
#undef PG8_SG
                    *(u32x2*)(rowp + bj * HALF) = o; } }
    }
};
struct EpiMergeF {
    static constexpr bool PERM = true, AFTER_DRAIN = false, HAS_MID = true, PROBE2 = false, FP8 = false;
    const unsigned char* gates; bf16_t* out;
    typedef unsigned u32x2 __attribute__((ext_vector_type(2)));
    static __device__ __forceinline__ float ub(unsigned w, int i) { return (float)((w >> (8 * i)) & 0xffu); }
    __device__ __forceinline__ void mid(f32x4 (&acc)[2][2][4][2], const Unit& u, int wr, int wc, int fr, int fq) const {
        int fr_ = fr, fq_ = fq; asm volatile("" : "+v"(fr_), "+v"(fq_));
        const PG8_GAS unsigned char* gp = (const PG8_GAS unsigned char*)gates + (size_t)(u.pm * BM + wr * 64 + fr_) * 2048 + (u.pn * BM + wc * 32 + 8 * fq_);
#pragma unroll
        for (int ai = 0; ai < 2; ++ai) {
#pragma unroll
            for (int m = 0; m < 4; ++m) {
#pragma unroll
                for (int bj = 0; bj < 2; ++bj) {
                    const u32x2 gd = *(const PG8_GAS u32x2*)(gp + bj * HALF), gw = *(const PG8_GAS u32x2*)(gp + 1024 + bj * HALF);
                    f32x4& v0 = acc[ai][bj][m][0]; f32x4& v1 = acc[ai][bj][m][1];
#pragma unroll
                    for (int i = 0; i < 4; ++i) { v0[i] *= ub(gd.x, i) * __builtin_amdgcn_rcpf(fmaxf(ub(gw.x, i), 1.f)); v1[i] *= ub(gd.y, i) * __builtin_amdgcn_rcpf(fmaxf(ub(gw.y, i), 1.f)); } }
                gp += 16 * 2048; asm volatile("" : "+v"(gp)); }
            gp += 64 * 2048; asm volatile("" : "+v"(gp)); }
    }
    __device__ __forceinline__ void operator()(const f32x4 (&acc)[2][2][4][2], const Unit& u, int wr, int wc, int fr, int fq) const {
        const int row0 = u.pm * BM + wr * 64 + fr; const int col0 = u.pn * BM + wc * 32 + 8 * fq;
        const PG8_GAS unsigned char* gp = (const PG8_GAS unsigned char*)gates + (size_t)row0 * 2048 + 1024 + col0; PG8_GAS bf16_t* op = (PG8_GAS bf16_t*)out + (size_t)row0 * 1024 + col0;
#pragma unroll
        for (int ai = 0; ai < 2; ++ai) {
#pragma unroll
            for (int m = 0; m < 4; ++m) {
#pragma unroll
                for (int bj = 0; bj < 2; ++bj) {
                    const u32x2 g = *(const PG8_GAS u32x2*)(gp + bj * HALF);
                    f32x4 v0 = acc[ai][bj][m][0], v1 = acc[ai][bj][m][1];
#pragma unroll
                    for (int i = 0; i < 4; ++i) { v0[i] *= fmaxf(ub(g.x, i), 1.f) * (1.0f / 255.0f); v1[i] *= fmaxf(ub(g.y, i), 1.f) * (1.0f / 255.0f); }
                    *(PG8_GAS u32x4*)(op + bj * HALF) = pack8(v0, v1); }
                gp += 16 * 2048; op += 16 * 1024; asm volatile("" : "+v"(gp), "+v"(op)); }
            gp += 64 * 2048; op += 64 * 1024; asm volatile("" : "+v"(gp), "+v"(op)); }
    }
};
struct EpiResid {
    static constexpr bool PERM = true, AFTER_DRAIN = false, HAS_MID = false, PROBE2 = false, FP8 = false;
    const bf16_t* base; bf16_t* out;
    __device__ __forceinline__ void operator()(const f32x4 (&acc)[2][2][4][2], const Unit& u, int wr, int wc, int fr, int fq) const {
        const size_t off0 = (size_t)(u.pm * BM + wr * 64 + fr) * 1024 + (u.pn * BM + wc * 32 + 8 * fq);
        const PG8_GAS bf16_t* bp = (const PG8_GAS bf16_t*)base + off0; PG8_GAS bf16_t* op = (PG8_GAS bf16_t*)out + off0;
#pragma unroll
        for (int ai = 0; ai < 2; ++ai) {
#pragma unroll
            for (int m = 0; m < 4; ++m) {
#pragma unroll
                for (int bj = 0; bj < 2; ++bj) { const u32x4 b = *(const PG8_GAS u32x4*)(bp + bj * HALF);
                    f32x4 v0 = acc[ai][bj][m][0], v1 = acc[ai][bj][m][1];
                    v0[0] += bf_lo(b.x); v0[1] += bf_hi(b.x); v0[2] += bf_lo(b.y); v0[3] += bf_hi(b.y);
                    v1[0] += bf_lo(b.z); v1[1] += bf_hi(b.z); v1[2] += bf_lo(b.w); v1[3] += bf_hi(b.w);
                    *(PG8_GAS u32x4*)(op + bj * HALF) = pack8(v0, v1); }
                bp += 16 * 1024; op += 16 * 1024; asm volatile("" : "+v"(bp), "+v"(op)); }
            bp += 64 * 1024; op += 64 * 1024; asm volatile("" : "+v"(bp), "+v"(op)); }
    }
};
struct EpiSwiGlu {
    static constexpr bool PERM = true, AFTER_DRAIN = false, HAS_MID = false, PROBE2 = false, FP8 = false;
    bf16_t* hid;
    __device__ __forceinline__ void operator()(const f32x4 (&acc)[2][2][4][2], const Unit& u, int wr, int wc, int fr, int fq) const {
        const int row0 = u.pm * BM + wr * 64 + fr; const int col0 = (u.pn & 3) * 128 + wc * 32 + 8 * fq;
#pragma unroll
        for (int ai = 0; ai < 2; ++ai)
#pragma unroll
            for (int m = 0; m < 4; ++m) { f32x4 h0, h1;
#pragma unroll
                for (int i = 0; i < 4; ++i) { const float g0 = acc[ai][0][m][0][i], g1 = acc[ai][0][m][1][i];
                    h0[i] = g0 * sigmoid_f(g0) * acc[ai][1][m][0][i]; h1[i] = g1 * sigmoid_f(g1) * acc[ai][1][m][1][i]; }
                *(u32x4*)(hid + (size_t)(row0 + ai * HALF + m * 16) * 512 + col0) = pack8(h0, h1); }
    }
};
struct EpiDown {
    static constexpr bool PERM = true, AFTER_DRAIN = false, HAS_MID = false, PROBE2 = (EPI_TWICE_MASK & 1) != 0, FP8 = false;
    bf16_t* O;
    __device__ __forceinline__ void operator()(const f32x4 (&acc)[2][2][4][2], const Unit& u, int wr, int wc, int fr, int fq) const {
        const int row0 = u.pm * BM + wr * 64 + fr; const int col0 = (u.pn & 3) * BM + wc * 32 + 8 * fq;
#pragma unroll
        for (int ai = 0; ai < 2; ++ai)
#pragma unroll
            for (int m = 0; m < 4; ++m) { bf16_t* rowp = O + (size_t)(row0 + ai * HALF + m * 16) * 1024 + col0;
#pragma unroll
                for (int bj = 0; bj < 2; ++bj) *(u32x4*)(rowp + bj * HALF) = pack8(acc[ai][bj][m][0], acc[ai][bj][m][1]); }
    }
};
constexpr float X8_MUL = 4.f, HID8_MUL = 8.f, WGU8_MUL = 32.f, WD8_MUL = 16.f;
__device__ __forceinline__ unsigned pk4_fp8(float a, float b, float c, float d) {
    a = fminf(fmaxf(a, -448.f), 448.f); b = fminf(fmaxf(b, -448.f), 448.f); c = fminf(fmaxf(c, -448.f), 448.f); d = fminf(fmaxf(d, -448.f), 448.f);
    int w = 0; w = __builtin_amdgcn_cvt_pk_fp8_f32(a, b, w, false); w = __builtin_amdgcn_cvt_pk_fp8_f32(c, d, w, true); return (unsigned)w;
}
struct EpiSwiGlu8 {
    static constexpr bool PERM = true, AFTER_DRAIN = false, HAS_MID = false, PROBE2 = false, FP8 = true;
    static constexpr int SCALE_X = 125, SCALE_W = 122;
    unsigned char* hid;
    __device__ __forceinline__ void operator()(const f32x4 (&acc)[2][2][4][2], const Unit& u, int wr, int wc, int fr, int fq) const {
        const int row0 = u.pm * BM + wr * 64 + fr; const int col0 = (u.pn & 3) * 128 + wc * 32 + 8 * fq;
#pragma unroll
        for (int ai = 0; ai < 2; ++ai)
#pragma unroll
            for (int m = 0; m < 4; ++m) { f32x4 h0, h1;
#pragma unroll
                for (int i = 0; i < 4; ++i) { const float g0 = acc[ai][0][m][0][i], g1 = acc[ai][0][m][1][i];
                    h0[i] = HID8_MUL * g0 * sigmoid_f(g0) * acc[ai][1][m][0][i]; h1[i] = HID8_MUL * g1 * sigmoid_f(g1) * acc[ai][1][m][1][i]; }
                f32x2 w; unsigned w0 = pk4_fp8(h0[0], h0[1], h0[2], h0[3]), w1 = pk4_fp8(h1[0], h1[1], h1[2], h1[3]);
                typedef unsigned u32x2 __attribute__((ext_vector_type(2))); u32x2 o; o.x = w0; o.y = w1;
                *(u32x2*)(hid + (size_t)(row0 + ai * HALF + m * 16) * 512 + col0) = o; (void)w; }
    }
};
constexpr float YS8_MUL = 16.f;
struct EpiDown8 {
    static constexpr bool PERM = true, AFTER_DRAIN = false, HAS_MID = false, PROBE2 = false, FP8 = true;
    static constexpr int SCALE_X = 124, SCALE_W = 123;
    unsigned char* O;
    __device__ __forceinline__ void operator()(const f32x4 (&acc)[2][2][4][2], const Unit& u, int wr, int wc, int fr, int fq) const {
        const int row0 = u.pm * BM + wr * 64 + fr; const int col0 = (u.pn & 3) * BM + wc * 32 + 8 * fq;
        typedef unsigned u32x2 __attribute__((ext_vector_type(2)));
#pragma unroll
        for (int ai = 0; ai < 2; ++ai)
#pragma unroll
            for (int m = 0; m < 4; ++m) { unsigned char* rowp = O + (size_t)(row0 + ai * HALF + m * 16) * 1024 + col0;
#pragma unroll
                for (int bj = 0; bj < 2; ++bj) { const f32x4 v0 = acc[ai][bj][m][0] * YS8_MUL, v1 = acc[ai][bj][m][1] * YS8_MUL;
                    u32x2 o; o.x = pk4_fp8(v0[0], v0[1], v0[2], v0[3]); o.y = pk4_fp8(v1[0], v1[1], v1[2], v1[3]);
                    *(u32x2*)(rowp + bj * HALF) = o; } }
    }
};
constexpr float O8_MUL = 8.f, PT8_MUL = 16.f, MRG8_MUL = 8.f, WO8_MUL = 32.f;
struct EpiMergeF8 {
    static constexpr bool PERM = true, AFTER_DRAIN = false, HAS_MID = true, PROBE2 = false, FP8 = true;
    static constexpr int SCALE_X = 124, SCALE_W = 123;
    const unsigned char* gates; unsigned char* out;
    typedef unsigned u32x2 __attribute__((ext_vector_type(2)));
    static __device__ __forceinline__ float ub(unsigned w, int i) { return (float)((w >> (8 * i)) & 0xffu); }
    __device__ __forceinline__ void mid(f32x4 (&acc)[2][2][4][2], const Unit& u, int wr, int wc, int fr, int fq) const {
        int fr_ = fr, fq_ = fq; asm volatile("" : "+v"(fr_), "+v"(fq_));
        const PG8_GAS unsigned char* gp = (const PG8_GAS unsigned char*)gates + (size_t)(u.pm * BM + wr * 64 + fr_) * 2048 + (u.pn * BM + wc * 32 + 8 * fq_);
        u32x2 gd[2][4][2], gw[2][4][2];
#pragma unroll
        for (int ai = 0; ai < 2; ++ai)
#pragma unroll
            for (int m = 0; m < 4; ++m)
#pragma unroll
                for (int bj = 0; bj < 2; ++bj) { gd[ai][m][bj] = *(const PG8_GAS u32x2*)(gp + (size_t)(ai * 128 + m * 16) * 2048 + bj * HALF); gw[ai][m][bj] = *(const PG8_GAS u32x2*)(gp + (size_t)(ai * 128 + m * 16) * 2048 + 1024 + bj * HALF); }
        __builtin_amdgcn_sched_barrier(0);
#pragma unroll
        for (int ai = 0; ai < 2; ++ai) {
#pragma unroll
            for (int m = 0; m < 4; ++m)
#pragma unroll
                for (int bj = 0; bj < 2; ++bj) { f32x4& v0 = acc[ai][bj][m][0]; f32x4& v1 = acc[ai][bj][m][1];
#pragma unroll
                    for (int i = 0; i < 4; ++i) { v0[i] *= ub(gd[ai][m][bj].x, i) * __builtin_amdgcn_rcpf(fmaxf(ub(gw[ai][m][bj].x, i), 1.f)); v1[i] *= ub(gd[ai][m][bj].y, i) * __builtin_amdgcn_rcpf(fmaxf(ub(gw[ai][m][bj].y, i), 1.f)); } }
            __builtin_amdgcn_sched_barrier(0); }
    }
    __device__ __forceinline__ void operator()(const f32x4 (&acc)[2][2][4][2], const Unit& u, int wr, int wc, int fr, int fq) const {
        const int row0 = u.pm * BM + wr * 64 + fr; const int col0 = u.pn * BM + wc * 32 + 8 * fq;
        const PG8_GAS unsigned char* gp = (const PG8_GAS unsigned char*)gates + (size_t)row0 * 2048 + 1024 + col0; PG8_GAS unsigned char* op = (PG8_GAS unsigned char*)out + (size_t)row0 * 1024 + col0;
#pragma unroll
        for (int ai = 0; ai < 2; ++ai) {
            u32x2 g[4][2];
#pragma unroll
            for (int m = 0; m < 4; ++m)
#pragma unroll
                for (int bj = 0; bj < 2; ++bj) g[m][bj] = *(const PG8_GAS u32x2*)(gp + (size_t)m * 16 * 2048 + bj * HALF);
            asm volatile("" : "+v"(g[0][0]), "+v"(g[0][1]), "+v"(g[1][0]), "+v"(g[1][1]), "+v"(g[2][0]), "+v"(g[2][1]), "+v"(g[3][0]), "+v"(g[3][1]));
#pragma unroll
            for (int m = 0; m < 4; ++m)
#pragma unroll
                for (int bj = 0; bj < 2; ++bj) {
                    f32x4 v0 = acc[ai][bj][m][0], v1 = acc[ai][bj][m][1];
#pragma unroll
                    for (int i = 0; i < 4; ++i) { v0[i] *= fmaxf(ub(g[m][bj].x, i), 1.f) * (MRG8_MUL / 255.0f); v1[i] *= fmaxf(ub(g[m][bj].y, i), 1.f) * (MRG8_MUL / 255.0f); }
                    u32x2 o; o.x = pk4_fp8(v0[0], v0[1], v0[2], v0[3]); o.y = pk4_fp8(v1[0], v1[1], v1[2], v1[3]);
                    *(PG8_GAS u32x2*)(op + (size_t)m * 16 * 1024 + bj * HALF) = o; }
            gp += 128 * 2048; op += 128 * 1024; asm volatile("" : "+v"(gp), "+v"(op)); }
    }
};
struct EpiResid8 {
    static constexpr bool PERM = true, AFTER_DRAIN = false, HAS_MID = false, PROBE2 = false, FP8 = true;
    static constexpr int SCALE_X = 124, SCALE_W = 122;
    const bf16_t* base; bf16_t* out;
    __device__ __forceinline__ void operator()(const f32x4 (&acc)[2][2][4][2], const Unit& u, int wr, int wc, int fr, int fq) const {
        const size_t off0 = (size_t)(u.pm * BM + wr * 64 + fr) * 1024 + (u.pn * BM + wc * 32 + 8 * fq);
        const PG8_GAS bf16_t* bp = (const PG8_GAS bf16_t*)base + off0; PG8_GAS bf16_t* op = (PG8_GAS bf16_t*)out + off0;
#pragma unroll
        for (int ai = 0; ai < 2; ++ai) {
            u32x4 b[4][2];
#pragma unroll
            for (int m = 0; m < 4; ++m)
#pragma unroll
                for (int bj = 0; bj < 2; ++bj) b[m][bj] = *(const PG8_GAS u32x4*)(bp + (size_t)m * 16 * 1024 + bj * HALF);
            asm volatile("" : "+v"(b[0][0]), "+v"(b[0][1]), "+v"(b[1][0]), "+v"(b[1][1]), "+v"(b[2][0]), "+v"(b[2][1]), "+v"(b[3][0]), "+v"(b[3][1]));
#pragma unroll
            for (int m = 0; m < 4; ++m)
#pragma unroll
                for (int bj = 0; bj < 2; ++bj) { const u32x4 bb = b[m][bj];
                    f32x4 v0 = acc[ai][bj][m][0], v1 = acc[ai][bj][m][1];
                    v0[0] += bf_lo(bb.x); v0[1] += bf_hi(bb.x); v0[2] += bf_lo(bb.y); v0[3] += bf_hi(bb.y);
                    v1[0] += bf_lo(bb.z); v1[1] += bf_hi(bb.z); v1[2] += bf_lo(bb.w); v1[3] += bf_hi(bb.w);
                    *(PG8_GAS u32x4*)(op + (size_t)m * 16 * 1024 + bj * HALF) = pack8(v0, v1); }
            bp += 128 * 1024; op += 128 * 1024; asm volatile("" : "+v"(bp), "+v"(op)); }
    }
};
struct MoeOrder {
    int nunits, G, c; const PG8_LAS int* tile_e; const PG8_LAS int* rowtab;
    __device__ __forceinline__ int arow(int ui, int r) const { return rowtab[ui * 256 + r]; }
    static __device__ __forceinline__ int unit_of(int L, int nunits) { const int q = nunits / NXCD, r = nunits % NXCD, xcd = L % NXCD, off = L / NXCD; return (xcd < r ? xcd * (q + 1) : r * (q + 1) + (xcd - r) * q) + off; }
    __device__ __forceinline__ bool next(int i, Unit& u) const { const int L = i * G + c; if (L >= nunits) return false; const int w = unit_of(L, nunits); u.pm = w >> 2; u.pn = __builtin_amdgcn_readfirstlane(tile_e[w >> 2]) * 4 + (w & 3); return true; }
    __device__ __forceinline__ void a_ready(const Unit&) const {}
    __device__ __forceinline__ void done(const Unit&) const {}
};

typedef int pg8_v8i __attribute__((ext_vector_type(8)));
typedef int pg8_v4i __attribute__((ext_vector_type(4)));
template <bool F8> struct pg8_fragT { bf16x8 q[2]; };
template <> struct pg8_fragT<true> { pg8_v8i v; };
__device__ __forceinline__ void pg8_mfma_f8(f32x4& acc, const pg8_v8i a, const pg8_v8i b, int sa, int sb) {
    asm volatile("v_mfma_scale_f32_16x16x128_f8f6f4 %0, %1, %2, %0, %3, %4 op_sel_hi:[0,0,0]" : "+v"(acc) : "v"(a), "v"(b), "v"(sa), "v"(sb));
}
template <class Epi, class Sched, bool ALIGN_EPI = false, bool SP2 = false>
__device__ __forceinline__ void gemm_phase(PG8_LAS unsigned char* lds, const Gemm g, const Sched& S, const Epi& E) {
    int tid_ = threadIdx.x; asm volatile("" : "+v"(tid_));
    const int tid = tid_, wid = __builtin_amdgcn_readfirstlane(tid >> 6), lane = tid & 63, wr = wid >> 2, wc = wid & 3, fr = lane & 15, fq = lane >> 4;
    int K_ = g.K; asm volatile("" : "+s"(K_));
    const int K = K_, nt = K / BK;
    unsigned voffA[2], voffB[2];
#pragma unroll
    for (int i = 0; i < 2; ++i) { int R, C; stage_rc(tid * 16 + i * 8192, R, C); const int Rb = Epi::PERM ? ((R & ~31) + perm32(R & 31)) : R;
        voffA[i] = (unsigned)(R * K + C) * 2u; voffB[i] = (unsigned)(Rb * K + C) * 2u; }
    const size_t kstep = (size_t)(BK * 2);
    const size_t hstep = (size_t)HALF * K * 2;
    const size_t tstep = 2 * hstep;
    const unsigned ldsw = (unsigned)wid * 1024u;
    const int aoff = lds_byte(wr * 64 + fr, fq * 8), boff = lds_byte(wc * 32 + fr, fq * 8);
#define PG8_SA(b, h) (((b) * 2 + (h)) * HTB)
#define PG8_SB(b, h) ((4 + (b) * 2 + (h)) * HTB)
#define PG8_STAGE(bufoff, gbase, voff) do { _Pragma("unroll") for (int _i = 0; _i < 2; ++_i) \
        __builtin_amdgcn_global_load_lds((const unsigned*)((const char*)(gbase) + (voff)[_i]), (PG8_LAS unsigned*)(lds + (bufoff) + ldsw + _i * 8192), 16, 0, 0); } while (0)
#define PG8_LDA(dst, b, h) do { _Pragma("unroll") for (int m = 0; m < 4; ++m) { if constexpr (Epi::FP8) { const pg8_v4i lo_ = *(const PG8_LAS pg8_v4i*)(lds + PG8_SA(b, h) + aoff + m * 2048), hi_ = *(const PG8_LAS pg8_v4i*)(lds + PG8_SA(b, h) + aoff + m * 2048 + 1024); \
        dst[m].v = __builtin_shufflevector(lo_, hi_, 0, 1, 2, 3, 4, 5, 6, 7); } else { _Pragma("unroll") for (int k = 0; k < 2; ++k) dst[m].q[k] = *(const PG8_LAS bf16x8*)(lds + PG8_SA(b, h) + aoff + m * 2048 + k * 1024); } } } while (0)
#define PG8_LDB(dst, b, h) do { _Pragma("unroll") for (int n = 0; n < 2; ++n) { if constexpr (Epi::FP8) { const pg8_v4i lo_ = *(const PG8_LAS pg8_v4i*)(lds + PG8_SB(b, h) + boff + n * 2048), hi_ = *(const PG8_LAS pg8_v4i*)(lds + PG8_SB(b, h) + boff + n * 2048 + 1024); \
        dst[n].v = __builtin_shufflevector(lo_, hi_, 0, 1, 2, 3, 4, 5, 6, 7); } else { _Pragma("unroll") for (int k = 0; k < 2; ++k) dst[n].q[k] = *(const PG8_LAS bf16x8*)(lds + PG8_SB(b, h) + boff + n * 2048 + k * 1024); } } } while (0)
#define PG8_MMA(ai, bj, At, Bt) do { __builtin_amdgcn_s_setprio(1); \
        if constexpr (Epi::FP8) {   \
            _Pragma("unroll") for (int m = 0; m < 4; ++m) _Pragma("unroll") for (int n = 0; n < 2; ++n) \
                pg8_mfma_f8(acc[ai][bj][m][n], Bt[n].v, At[m].v, sclW, sclX); \
        } else { _Pragma("unroll") for (int m = 0; m < 4; ++m) _Pragma("unroll") for (int n = 0; n < 2; ++n) _Pragma("unroll") for (int k = 0; k < 2; ++k) \
            acc[ai][bj][m][n] = __builtin_amdgcn_mfma_f32_16x16x32_bf16(Bt[n].q[k], At[m].q[k], acc[ai][bj][m][n], 0, 0, 0); } \
        __builtin_amdgcn_s_setprio(0); } while (0)
#define PG8_WAIT_V(n) asm volatile("s_waitcnt vmcnt(" #n ")" ::: "memory")
#define PG8_WAIT_L(n) asm volatile("s_waitcnt lgkmcnt(" #n ")" ::: "memory")
#define PG8_BAR __builtin_amdgcn_s_barrier()
#define PG8_SCHED __builtin_amdgcn_sched_barrier(0)
    Unit cur, nxt; int ui = 0;
    if (!S.next(0, cur)) return;
    f32x4 acc[2][2][4][2];
#pragma unroll
    for (int a = 0; a < 2; ++a)
#pragma unroll
        for (int b = 0; b < 2; ++b)
#pragma unroll
            for (int m = 0; m < 4; ++m)
#pragma unroll
                for (int n = 0; n < 2; ++n) acc[a][b][m][n] = (f32x4){0.f, 0.f, 0.f, 0.f};
    pg8_fragT<Epi::FP8> At[4], B0[2], B1[2];
    int sclW = 0, sclX = 0; if constexpr (Epi::FP8) { sclW = Epi::SCALE_W; sclX = Epi::SCALE_X; asm volatile("" : "+v"(sclW), "+v"(sclX)); }
    const char* cA = (const char*)g.A + (size_t)cur.pm * tstep; const char* cB = (const char*)g.Bt + (size_t)cur.pn * tstep;
    S.a_ready(cur);
    if constexpr (SP2) {
        PG8_STAGE(PG8_SB(0, 0), cB, voffB); PG8_STAGE(PG8_SB(0, 1), cB + hstep, voffB); PG8_STAGE(PG8_SA(0, 0), cA, voffA); PG8_STAGE(PG8_SA(0, 1), cA + hstep, voffA);
        if (wr == 1) PG8_BAR;
        PG8_WAIT_V(2); PG8_BAR;
        PG8_STAGE(PG8_SB(1, 0), cB + kstep, voffB); PG8_STAGE(PG8_SA(1, 0), cA + kstep, voffA); PG8_STAGE(PG8_SB(1, 1), cB + hstep + kstep, voffB);
        PG8_WAIT_V(6); PG8_BAR;
    } else {
        PG8_STAGE(PG8_SB(0, 0), cB, voffB); PG8_STAGE(PG8_SA(0, 0), cA, voffA); PG8_STAGE(PG8_SB(0, 1), cB + hstep, voffB); PG8_STAGE(PG8_SA(0, 1), cA + hstep, voffA);
        if (wr == 1) PG8_BAR;
        PG8_WAIT_V(4); PG8_BAR;
        PG8_STAGE(PG8_SB(1, 0), cB + kstep, voffB); PG8_STAGE(PG8_SA(1, 0), cA + kstep, voffA); PG8_STAGE(PG8_SB(1, 1), cB + hstep + kstep, voffB);
        PG8_WAIT_V(6); PG8_BAR;
    }
    for (;;) {
        const bool has_next = S.next(ui + 1, nxt);
        const char* nA = has_next ? (const char*)g.A + (size_t)nxt.pm * tstep : cA; const char* nB = has_next ? (const char*)g.Bt + (size_t)nxt.pn * tstep : cB;
#pragma unroll 1
        for (int t = 0; t < nt; t += 2) {
            if constexpr (Epi::HAS_MID) { if (t == (nt >> 1)) { if constexpr (Epi::FP8) asm volatile("s_nop 7\n\ts_nop 7\n\ts_nop 7" ::: "memory"); E.mid(acc, cur, wr, wc, fr, fq); } }
            const bool last = (t == nt - 2);
            const char* a1 = cA + (size_t)(t + 1) * kstep;
            const char* a2 = last ? nA : cA + (size_t)(t + 2) * kstep; const char* b2 = last ? nB : cB + (size_t)(t + 2) * kstep;
            const char* a3 = a2 + kstep; const char* b3 = b2 + kstep;
            if (last && has_next) S.a_ready(nxt);
            if constexpr (SP2) {
            PG8_LDB(B0, 0, 0); PG8_LDB(B1, 0, 1); PG8_SCHED; PG8_LDA(At, 0, 0); PG8_STAGE(PG8_SA(1, 1), a1 + hstep, voffA);
            PG8_WAIT_V(8); PG8_WAIT_L(0); PG8_BAR; PG8_MMA(0, 0, At, B0); PG8_MMA(0, 1, At, B1); PG8_BAR; PG8_SCHED;
            PG8_LDA(At, 0, 1); PG8_STAGE(PG8_SB(0, 0), b2, voffB); PG8_STAGE(PG8_SB(0, 1), b2 + hstep, voffB); PG8_STAGE(PG8_SA(0, 0), a2, voffA);
            PG8_WAIT_V(8); PG8_WAIT_L(0); PG8_BAR; PG8_MMA(1, 0, At, B0); PG8_MMA(1, 1, At, B1); PG8_BAR; PG8_SCHED;
            PG8_LDB(B0, 1, 0); PG8_LDB(B1, 1, 1); PG8_SCHED; PG8_LDA(At, 1, 0); PG8_STAGE(PG8_SA(0, 1), a2 + hstep, voffA);
            PG8_WAIT_V(8); PG8_WAIT_L(0); PG8_BAR; PG8_MMA(0, 0, At, B0); PG8_MMA(0, 1, At, B1); PG8_BAR; PG8_SCHED;
            PG8_LDA(At, 1, 1); PG8_STAGE(PG8_SB(1, 0), b3, voffB); PG8_STAGE(PG8_SB(1, 1), b3 + hstep, voffB); PG8_STAGE(PG8_SA(1, 0), a3, voffA);
            PG8_WAIT_V(8); PG8_WAIT_L(0); PG8_BAR; PG8_MMA(1, 0, At, B0); PG8_MMA(1, 1, At, B1); PG8_BAR; PG8_SCHED;
            } else {
            PG8_LDB(B0, 0, 0); PG8_SCHED; PG8_LDA(At, 0, 0); PG8_STAGE(PG8_SA(1, 1), a1 + hstep, voffA);
            PG8_WAIT_L(8); PG8_BAR; PG8_WAIT_L(0); PG8_MMA(0, 0, At, B0); PG8_BAR; PG8_SCHED;
            PG8_LDB(B1, 0, 1); PG8_STAGE(PG8_SB(0, 0), b2, voffB);
            PG8_BAR; PG8_WAIT_L(0); PG8_MMA(0, 1, At, B1); PG8_BAR;
            PG8_LDA(At, 0, 1); PG8_STAGE(PG8_SA(0, 0), a2, voffA);
            PG8_BAR; PG8_WAIT_L(0); PG8_MMA(1, 0, At, B0); PG8_BAR; PG8_SCHED;
            PG8_STAGE(PG8_SB(0, 1), b2 + hstep, voffB);
            PG8_WAIT_V(6); PG8_BAR; PG8_MMA(1, 1, At, B1); PG8_BAR;
            PG8_LDB(B0, 1, 0); PG8_SCHED; PG8_LDA(At, 1, 0); PG8_STAGE(PG8_SA(0, 1), a2 + hstep, voffA);
            PG8_WAIT_L(8); PG8_BAR; PG8_WAIT_L(0); PG8_MMA(0, 0, At, B0); PG8_BAR; PG8_SCHED;
            PG8_LDB(B1, 1, 1); PG8_STAGE(PG8_SB(1, 0), b3, voffB);
            PG8_BAR; PG8_WAIT_L(0); PG8_MMA(0, 1, At, B1); PG8_BAR;
            PG8_LDA(At, 1, 1); PG8_STAGE(PG8_SA(1, 0), a3, voffA);
            PG8_BAR; PG8_WAIT_L(0); PG8_MMA(1, 0, At, B0); PG8_BAR; PG8_SCHED;
            PG8_STAGE(PG8_SB(1, 1), b3 + hstep, voffB);
            PG8_WAIT_V(6); PG8_BAR; PG8_MMA(1, 1, At, B1); PG8_BAR;
            }
        }
        if constexpr (ALIGN_EPI) { if (wr == 0) PG8_BAR; }
        if constexpr (Epi::FP8) asm volatile("s_nop 7\n\ts_nop 7\n\ts_nop 7" ::: "memory");
        if constexpr (!Epi::AFTER_DRAIN) { E(acc, cur, wr, wc, fr, fq);
#ifdef EPI_TWICE
            if constexpr (Epi::PROBE2) { asm volatile("" ::: "memory"); E(acc, cur, wr, wc, fr, fq); }
#endif
            S.done(cur); }
        if (!has_next) break;
#pragma unroll
        for (int a = 0; a < 2; ++a)
#pragma unroll
            for (int b = 0; b < 2; ++b)
#pragma unroll
                for (int m = 0; m < 4; ++m)
#pragma unroll
                    for (int n = 0; n < 2; ++n) acc[a][b][m][n] = (f32x4){0.f, 0.f, 0.f, 0.f};
        cur = nxt; cA = nA; cB = nB; ++ui;
        if constexpr (ALIGN_EPI) { if (wr == 1) PG8_BAR; }
    }
    PG8_WAIT_V(0);
    if constexpr (!ALIGN_EPI) { if (wr == 0) PG8_BAR; }
    PG8_BAR;
    if constexpr (Epi::AFTER_DRAIN) { E.fused(acc, cur, wr, wc, fr, fq, lds, wid, lane); S.done(cur); }
#undef PG8_SA
#undef PG8_SB
#undef PG8_STAGE
#undef PG8_LDA
#undef PG8_LDB
#undef PG8_MMA
#undef PG8_WAIT_V
#undef PG8_WAIT_L
#undef PG8_BAR
#undef PG8_SCHED
}
template <class Epi, class Sched, bool ALIGN_EPI = false, bool SP2 = true>
__device__ __forceinline__ void gemm_phase_gather(PG8_LAS unsigned char* lds, const Gemm g, const Sched& S, const Epi& E) {
    int tid_ = threadIdx.x; asm volatile("" : "+v"(tid_));
    const int tid = tid_, wid = __builtin_amdgcn_readfirstlane(tid >> 6), lane = tid & 63, wr = wid >> 2, wc = wid & 3, fr = lane & 15, fq = lane >> 4;
    int K_ = g.K; asm volatile("" : "+s"(K_));
    const int K = K_, nt = K / BK;
    unsigned voffA[2], voffB[2];
    int Rr[2], Cc[2];
#pragma unroll
    for (int i = 0; i < 2; ++i) { int R, C; stage_rc(tid * 16 + i * 8192, R, C); const int Rb = Epi::PERM ? ((R & ~31) + perm32(R & 31)) : R; Rr[i] = R; Cc[i] = C;
        voffA[i] = (unsigned)(R * K + C) * 2u; voffB[i] = (unsigned)(Rb * K + C) * 2u; }
    static_assert(SP2, "the gather variant keeps only the SP2 loop");
    unsigned vA0[2], vA1[2], nA0[2], nA1[2];
#define PG8_GOFF(d0, d1, UI) do { _Pragma("unroll") for (int _i = 0; _i < 2; ++_i) { d0[_i] = (unsigned)(S.arow((UI), Rr[_i]) * K + Cc[_i]) * 2u; d1[_i] = (unsigned)(S.arow((UI), HALF + Rr[_i]) * K + Cc[_i]) * 2u; } } while (0)
    const size_t kstep = (size_t)(BK * 2);
    const size_t hstep = (size_t)HALF * K * 2;
    const size_t tstep = 2 * hstep;
    const unsigned ldsw = (unsigned)wid * 1024u;
    const int aoff = lds_byte(wr * 64 + fr, fq * 8), boff = lds_byte(wc * 32 + fr, fq * 8);
#define PG8_SA(b, h) (((b) * 2 + (h)) * HTB)
#define PG8_SB(b, h) ((4 + (b) * 2 + (h)) * HTB)
#define PG8_STAGE(bufoff, gbase, voff) do { _Pragma("unroll") for (int _i = 0; _i < 2; ++_i) \
        __builtin_amdgcn_global_load_lds((const unsigned*)((const char*)(gbase) + (voff)[_i]), (PG8_LAS unsigned*)(lds + (bufoff) + ldsw + _i * 8192), 16, 0, 0); } while (0)
#define PG8_LDA(dst, b, h) do { _Pragma("unroll") for (int m = 0; m < 4; ++m) { if constexpr (Epi::FP8) { const pg8_v4i lo_ = *(const PG8_LAS pg8_v4i*)(lds + PG8_SA(b, h) + aoff + m * 2048), hi_ = *(const PG8_LAS pg8_v4i*)(lds + PG8_SA(b, h) + aoff + m * 2048 + 1024); \
        dst[m].v = __builtin_shufflevector(lo_, hi_, 0, 1, 2, 3, 4, 5, 6, 7); } else { _Pragma("unroll") for (int k = 0; k < 2; ++k) dst[m].q[k] = *(const PG8_LAS bf16x8*)(lds + PG8_SA(b, h) + aoff + m * 2048 + k * 1024); } } } while (0)
#define PG8_LDB(dst, b, h) do { _Pragma("unroll") for (int n = 0; n < 2; ++n) { if constexpr (Epi::FP8) { const pg8_v4i lo_ = *(const PG8_LAS pg8_v4i*)(lds + PG8_SB(b, h) + boff + n * 2048), hi_ = *(const PG8_LAS pg8_v4i*)(lds + PG8_SB(b, h) + boff + n * 2048 + 1024); \
        dst[n].v = __builtin_shufflevector(lo_, hi_, 0, 1, 2, 3, 4, 5, 6, 7); } else { _Pragma("unroll") for (int k = 0; k < 2; ++k) dst[n].q[k] = *(const PG8_LAS bf16x8*)(lds + PG8_SB(b, h) + boff + n * 2048 + k * 1024); } } } while (0)
#define PG8_MMA(ai, bj, At, Bt) do { __builtin_amdgcn_s_setprio(1); \
        if constexpr (Epi::FP8) {   \
            _Pragma("unroll") for (int m = 0; m < 4; ++m) _Pragma("unroll") for (int n = 0; n < 2; ++n) \
                pg8_mfma_f8(acc[ai][bj][m][n], Bt[n].v, At[m].v, sclW, sclX); \
        } else { _Pragma("unroll") for (int m = 0; m < 4; ++m) _Pragma("unroll") for (int n = 0; n < 2; ++n) _Pragma("unroll") for (int k = 0; k < 2; ++k) \
            acc[ai][bj][m][n] = __builtin_amdgcn_mfma_f32_16x16x32_bf16(Bt[n].q[k], At[m].q[k], acc[ai][bj][m][n], 0, 0, 0); } \
        __builtin_amdgcn_s_setprio(0); } while (0)
#define PG8_WAIT_V(n) asm volatile("s_waitcnt vmcnt(" #n ")" ::: "memory")
#define PG8_WAIT_L(n) asm volatile("s_waitcnt lgkmcnt(" #n ")" ::: "memory")
#define PG8_BAR __builtin_amdgcn_s_barrier()
#define PG8_SCHED __builtin_amdgcn_sched_barrier(0)
    Unit cur, nxt; int ui = 0;
    if (!S.next(0, cur)) return;
    f32x4 acc[2][2][4][2];
#pragma unroll
    for (int a = 0; a < 2; ++a)
#pragma unroll
        for (int b = 0; b < 2; ++b)
#pragma unroll
            for (int m = 0; m < 4; ++m)
#pragma unroll
                for (int n = 0; n < 2; ++n) acc[a][b][m][n] = (f32x4){0.f, 0.f, 0.f, 0.f};
    pg8_fragT<Epi::FP8> At[4], B0[2], B1[2];
    int sclW = 0, sclX = 0; if constexpr (Epi::FP8) { sclW = Epi::SCALE_W; sclX = Epi::SCALE_X; asm volatile("" : "+v"(sclW), "+v"(sclX)); }
    const char* cA = (const char*)g.A; const char* cB = (const char*)g.Bt + (size_t)cur.pn * tstep;
    PG8_GOFF(vA0, vA1, 0);
    S.a_ready(cur);
    if constexpr (SP2) {
        PG8_STAGE(PG8_SB(0, 0), cB, voffB); PG8_STAGE(PG8_SB(0, 1), cB + hstep, voffB); PG8_STAGE(PG8_SA(0, 0), cA, vA0); PG8_STAGE(PG8_SA(0, 1), cA, vA1);
        if (wr == 1) PG8_BAR;
        PG8_WAIT_V(2); PG8_BAR;
        PG8_STAGE(PG8_SB(1, 0), cB + kstep, voffB); PG8_STAGE(PG8_SA(1, 0), cA + kstep, vA0); PG8_STAGE(PG8_SB(1, 1), cB + hstep + kstep, voffB);
        PG8_WAIT_V(6); PG8_BAR;
    } else {
        PG8_STAGE(PG8_SB(0, 0), cB, voffB); PG8_STAGE(PG8_SA(0, 0), cA, voffA); PG8_STAGE(PG8_SB(0, 1), cB + hstep, voffB); PG8_STAGE(PG8_SA(0, 1), cA + hstep, voffA);
        if (wr == 1) PG8_BAR;
        PG8_WAIT_V(4); PG8_BAR;
        PG8_STAGE(PG8_SB(1, 0), cB + kstep, voffB); PG8_STAGE(PG8_SA(1, 0), cA + kstep, voffA); PG8_STAGE(PG8_SB(1, 1), cB + hstep + kstep, voffB);
        PG8_WAIT_V(6); PG8_BAR;
    }
    for (;;) {
        const bool has_next = S.next(ui + 1, nxt);
        const char* nA = cA; const char* nB = has_next ? (const char*)g.Bt + (size_t)nxt.pn * tstep : cB;
        if (has_next) PG8_GOFF(nA0, nA1, ui + 1); else { nA0[0] = vA0[0]; nA0[1] = vA0[1]; nA1[0] = vA1[0]; nA1[1] = vA1[1]; }
#pragma unroll 1
        for (int t = 0; t < nt; t += 2) {
            if constexpr (Epi::HAS_MID) { if (t == (nt >> 1)) { if constexpr (Epi::FP8) asm volatile("s_nop 7\n\ts_nop 7\n\ts_nop 7" ::: "memory"); E.mid(acc, cur, wr, wc, fr, fq); } }
            const bool last = (t == nt - 2);
            const char* a1 = cA + (size_t)(t + 1) * kstep;
            const char* a2 = last ? nA : cA + (size_t)(t + 2) * kstep; const char* b2 = last ? nB : cB + (size_t)(t + 2) * kstep;
            const char* a3 = a2 + kstep; const char* b3 = b2 + kstep;
            if (last && has_next) S.a_ready(nxt);
            const unsigned wA0[2] = {last ? nA0[0] : vA0[0], last ? nA0[1] : vA0[1]}, wA1[2] = {last ? nA1[0] : vA1[0], last ? nA1[1] : vA1[1]};
            if constexpr (SP2) {
            PG8_LDB(B0, 0, 0); PG8_LDB(B1, 0, 1); PG8_SCHED; PG8_LDA(At, 0, 0); PG8_STAGE(PG8_SA(1, 1), a1, vA1);
            PG8_WAIT_V(8); PG8_WAIT_L(0); PG8_BAR; PG8_MMA(0, 0, At, B0); PG8_MMA(0, 1, At, B1); PG8_BAR; PG8_SCHED;
            PG8_LDA(At, 0, 1); PG8_STAGE(PG8_SB(0, 0), b2, voffB); PG8_STAGE(PG8_SB(0, 1), b2 + hstep, voffB); PG8_STAGE(PG8_SA(0, 0), a2, wA0);
            PG8_WAIT_V(8); PG8_WAIT_L(0); PG8_BAR; PG8_MMA(1, 0, At, B0); PG8_MMA(1, 1, At, B1); PG8_BAR; PG8_SCHED;
            PG8_LDB(B0, 1, 0); PG8_LDB(B1, 1, 1); PG8_SCHED; PG8_LDA(At, 1, 0); PG8_STAGE(PG8_SA(0, 1), a2, wA1);
            PG8_WAIT_V(8); PG8_WAIT_L(0); PG8_BAR; PG8_MMA(0, 0, At, B0); PG8_MMA(0, 1, At, B1); PG8_BAR; PG8_SCHED;
            PG8_LDA(At, 1, 1); PG8_STAGE(PG8_SB(1, 0), b3, voffB); PG8_STAGE(PG8_SB(1, 1), b3 + hstep, voffB); PG8_STAGE(PG8_SA(1, 0), a3, wA0);
            PG8_WAIT_V(8); PG8_WAIT_L(0); PG8_BAR; PG8_MMA(1, 0, At, B0); PG8_MMA(1, 1, At, B1); PG8_BAR; PG8_SCHED;
            } else {
            PG8_LDB(B0, 0, 0); PG8_SCHED; PG8_LDA(At, 0, 0); PG8_STAGE(PG8_SA(1, 1), a1 + hstep, voffA);
            PG8_WAIT_L(8); PG8_BAR; PG8_WAIT_L(0); PG8_MMA(0, 0, At, B0); PG8_BAR; PG8_SCHED;
            PG8_LDB(B1, 0, 1); PG8_STAGE(PG8_SB(0, 0), b2, voffB);
            PG8_BAR; PG8_WAIT_L(0); PG8_MMA(0, 1, At, B1); PG8_BAR;
            PG8_LDA(At, 0, 1); PG8_STAGE(PG8_SA(0, 0), a2, voffA);
            PG8_BAR; PG8_WAIT_L(0); PG8_MMA(1, 0, At, B0); PG8_BAR; PG8_SCHED;
            PG8_STAGE(PG8_SB(0, 1), b2 + hstep, voffB);
            PG8_WAIT_V(6); PG8_BAR; PG8_MMA(1, 1, At, B1); PG8_BAR;
            PG8_LDB(B0, 1, 0); PG8_SCHED; PG8_LDA(At, 1, 0); PG8_STAGE(PG8_SA(0, 1), a2 + hstep, voffA);
            PG8_WAIT_L(8); PG8_BAR; PG8_WAIT_L(0); PG8_MMA(0, 0, At, B0); PG8_BAR; PG8_SCHED;
            PG8_LDB(B1, 1, 1); PG8_STAGE(PG8_SB(1, 0), b3, voffB);
            PG8_BAR; PG8_WAIT_L(0); PG8_MMA(0, 1, At, B1); PG8_BAR;
            PG8_LDA(At, 1, 1); PG8_STAGE(PG8_SA(1, 0), a3, voffA);
            PG8_BAR; PG8_WAIT_L(0); PG8_MMA(1, 0, At, B0); PG8_BAR; PG8_SCHED;
            PG8_STAGE(PG8_SB(1, 1), b3 + hstep, voffB);
            PG8_WAIT_V(6); PG8_BAR; PG8_MMA(1, 1, At, B1); PG8_BAR;
            }
        }
        if constexpr (ALIGN_EPI) { if (wr == 0) PG8_BAR; }
        if constexpr (Epi::FP8) asm volatile("s_nop 7\n\ts_nop 7\n\ts_nop 7" ::: "memory");
        if constexpr (!Epi::AFTER_DRAIN) { E(acc, cur, wr, wc, fr, fq);
#ifdef EPI_TWICE
            if constexpr (Epi::PROBE2) { asm volatile("" ::: "memory"); E(acc, cur, wr, wc, fr, fq); }
#endif
            S.done(cur); }
        if (!has_next) break;
#pragma unroll
        for (int a = 0; a < 2; ++a)
#pragma unroll
            for (int b = 0; b < 2; ++b)
#pragma unroll
                for (int m = 0; m < 4; ++m)
#pragma unroll
                    for (int n = 0; n < 2; ++n) acc[a][b][m][n] = (f32x4){0.f, 0.f, 0.f, 0.f};
        cur = nxt; cA = nA; cB = nB; ++ui; vA0[0] = nA0[0]; vA0[1] = nA0[1]; vA1[0] = nA1[0]; vA1[1] = nA1[1];
        if constexpr (ALIGN_EPI) { if (wr == 1) PG8_BAR; }
    }
    PG8_WAIT_V(0);
    if constexpr (!ALIGN_EPI) { if (wr == 0) PG8_BAR; }
    PG8_BAR;
    if constexpr (Epi::AFTER_DRAIN) { E.fused(acc, cur, wr, wc, fr, fq, lds, wid, lane); S.done(cur); }
#undef PG8_SA
#undef PG8_SB
#undef PG8_STAGE
#undef PG8_LDA
#undef PG8_LDB
#undef PG8_MMA
#undef PG8_WAIT_V
#undef PG8_WAIT_L
#undef PG8_BAR
#undef PG8_SCHED
#undef PG8_GOFF
}
}

namespace att {
using bf16 = unsigned short;
using bf16x8 = __attribute__((ext_vector_type(8))) short;
using s16x4 = __attribute__((ext_vector_type(4))) short;
using f32x16 = __attribute__((ext_vector_type(16))) float;
using f32x4 = __attribute__((ext_vector_type(4))) float;
using u32x4 = __attribute__((ext_vector_type(4))) unsigned;
constexpr int SEQ = 2048, LDQKV = 2304, LDO = 1024;
constexpr int SLOT = 16384, NSLOT = 4;
constexpr int A_K = 0, A_V = NSLOT * SLOT, A_WS = 2 * NSLOT * SLOT, A_TAB = A_WS + 2048, A_END = A_TAB + 16384, A_XCH = 0;
constexpr float CS = 0.125f * 1.4426950408889634f;
constexpr float LOG2E = 1.4426950408889634f;
constexpr float THR = 8.f;
#define ATT_SBAR() __builtin_amdgcn_sched_barrier(0)
__device__ __forceinline__ int crow(int r, int hi) { return (r & 3) + 8 * (r >> 2) + 4 * hi; }
__device__ __forceinline__ unsigned cvtpk(float lo, float hi) { unsigned r; asm("v_cvt_pk_bf16_f32 %0, %1, %2" : "=v"(r) : "v"(lo), "v"(hi)); return r; }
__device__ __forceinline__ int t5_bucket(int rel) { const int n = rel < 0 ? -rel : rel; int b = n; if (n >= 8) { b = (31 - __builtin_clz((unsigned)(n * n))) + 2; b = b > 15 ? 15 : b; } return (rel > 0 ? 16 : 0) + b; }

template <int KC> __device__ __forceinline__ int kswz(int row, int colB) { return row * (KC * 2) + (colB ^ ((row & 7) << 4)); }
template <int DV> __device__ __forceinline__ int v_st(int k, int c) { const int kk = (k & ~0xC) | ((k & 4) << 1) | ((k & 8) >> 1); return ((kk >> 3) * (DV / 32) + (c >> 5)) * 512 + ((kk & 7) * 32 + (c & 31)) * 2; }
__device__ __forceinline__ int v_rd_base(int lane) { return ((lane & 3) << 3) | (((lane >> 2) & 3) << 6) | (((lane >> 4) & 1) << 5) | (((lane >> 5) & 1) << 8); }
template <int OFF> __device__ __forceinline__ s16x4 tr_read(int vb) { s16x4 r; asm volatile("ds_read_b64_tr_b16 %0, %1 offset:%2" : "=&v"(r) : "v"(vb), "i"(OFF) : "memory"); return r; }

__device__ __forceinline__ void glds16(const void* sbase, unsigned voff, unsigned lds_dst) {
  unsigned keep;
  asm volatile("s_mov_b32 %0, m0\n\ts_mov_b32 m0, %3\n\ts_nop 0\n\tglobal_load_lds_dwordx4 %1, %2\n\ts_mov_b32 m0, %0" : "=&s"(keep) : "v"(voff), "s"(sbase), "s"(lds_dst) : "memory");
}
#define ATT_DECIDE(PMAX) do { if (__builtin_expect(__all((PMAX) - m_reg <= THR), 1)) { mn = m_reg; alpha = 1.f; } \
    else { mn = fmaxf(m_reg, (PMAX)); alpha = __builtin_amdgcn_exp2f(m_reg - mn); m_reg = mn; } } while (0)
__device__ __forceinline__ void partialSM(f32x16& p0, f32x16& p1, float& m_reg, float& alpha, bool use_tab, float cf, const float* tp) {
  float mn;
  if (use_tab) {
#pragma unroll
    for (int r = 0; r < 16; ++r) { const int co = (r & 3) + 8 * (r >> 2); p0[r] = fmaf(p0[r], CS, tp[co]); p1[r] = fmaf(p1[r], CS, tp[32 + co]); }
  }
  float mx0 = fmaxf(p0[0], p0[1]), mx1 = fmaxf(p0[2], p0[3]), mx2 = fmaxf(p1[0], p1[1]), mx3 = fmaxf(p1[2], p1[3]);
#pragma unroll
  for (int r = 4; r < 16; r += 4) { mx0 = fmaxf(fmaxf(mx0, p0[r]), p0[r + 1]); mx1 = fmaxf(fmaxf(mx1, p0[r + 2]), p0[r + 3]); mx2 = fmaxf(fmaxf(mx2, p1[r]), p1[r + 1]); mx3 = fmaxf(fmaxf(mx3, p1[r + 2]), p1[r + 3]); }
  float pmax = fmaxf(fmaxf(mx0, mx1), fmaxf(mx2, mx3));
  { auto rr = __builtin_amdgcn_permlane32_swap(__float_as_uint(pmax), __float_as_uint(pmax), false, false);
    pmax = fmaxf(__uint_as_float(rr[0]), __uint_as_float(rr[1])); }
  if (use_tab) {
    ATT_DECIDE(pmax);
#pragma unroll
    for (int r = 0; r < 16; ++r) { p0[r] = __builtin_amdgcn_exp2f(p0[r] - mn); p1[r] -= mn; }
  } else {
    pmax = fmaf(pmax, CS, cf);
    ATT_DECIDE(pmax);
    const float off = cf - mn;
#pragma unroll
    for (int r = 0; r < 16; ++r) { p0[r] = __builtin_amdgcn_exp2f(fmaf(p0[r], CS, off)); p1[r] = fmaf(p1[r], CS, off); }
  }
}
#undef ATT_DECIDE
__device__ __forceinline__ void sm_pre(f32x16& p0, f32x16& p1, const float* tp) {
#pragma unroll
  for (int r = 0; r < 16; ++r) { const int co = (r & 3) + 8 * (r >> 2); p0[r] = fmaf(p0[r], CS, tp[co]); p1[r] = fmaf(p1[r], CS, tp[32 + co]); }
}
__device__ __forceinline__ float sm_max(const f32x16& p0, const f32x16& p1) {
  float mx0 = fmaxf(p0[0], p0[1]), mx1 = fmaxf(p0[2], p0[3]), mx2 = fmaxf(p1[0], p1[1]), mx3 = fmaxf(p1[2], p1[3]);
#pragma unroll
  for (int r = 4; r < 16; r += 4) { mx0 = fmaxf(fmaxf(mx0, p0[r]), p0[r + 1]); mx1 = fmaxf(fmaxf(mx1, p0[r + 2]), p0[r + 3]); mx2 = fmaxf(fmaxf(mx2, p1[r]), p1[r + 1]); mx3 = fmaxf(fmaxf(mx3, p1[r + 2]), p1[r + 3]); }
  float pmax = fmaxf(fmaxf(mx0, mx1), fmaxf(mx2, mx3));
  auto rr = __builtin_amdgcn_permlane32_swap(__float_as_uint(pmax), __float_as_uint(pmax), false, false);
  return fmaxf(__uint_as_float(rr[0]), __uint_as_float(rr[1]));
}
__device__ __forceinline__ void sm_dec(float pmax, bool use_tab, float cf, float& m_reg, float& alpha, float& scale, float& off) {
  if (!use_tab) pmax = fmaf(pmax, CS, cf);
  const bool keep = __all(pmax - m_reg <= THR);
  const float mn = keep ? m_reg : fmaxf(m_reg, pmax);
  alpha = __builtin_amdgcn_exp2f(m_reg - mn); m_reg = mn;
  scale = use_tab ? 1.0f : CS; off = use_tab ? -mn : cf - mn;
}
template <int LO, int HI> __device__ __forceinline__ void sm_exp(f32x16& p0, float scale, float off) {
#pragma unroll
  for (int r = LO; r < HI; ++r) p0[r] = __builtin_amdgcn_exp2f(fmaf(p0[r], scale, off));
}
__device__ __forceinline__ void sm_sub(f32x16& p1, float scale, float off) {
#pragma unroll
  for (int r = 0; r < 16; ++r) p1[r] = fmaf(p1[r], scale, off);
}
__device__ __forceinline__ void finishSM(f32x16& p0, f32x16& p1, float alpha, float& l_reg, bf16x8& pa0, bf16x8& pa1, bf16x8& pa2, bf16x8& pa3) {
#pragma unroll
  for (int r = 0; r < 16; ++r) p1[r] = __builtin_amdgcn_exp2f(p1[r]);
  float ps0 = p0[0] + p0[1], ps1 = p0[2] + p0[3], ps2 = p1[0] + p1[1], ps3 = p1[2] + p1[3];
#pragma unroll
  for (int r = 4; r < 16; r += 4) { ps0 += p0[r] + p0[r + 1]; ps1 += p0[r + 2] + p0[r + 3]; ps2 += p1[r] + p1[r + 1]; ps3 += p1[r + 2] + p1[r + 3]; }
  float ps = (ps0 + ps1) + (ps2 + ps3);
  { auto rr = __builtin_amdgcn_permlane32_swap(__float_as_uint(ps), __float_as_uint(ps), false, false);
    ps = __uint_as_float(rr[0]) + __uint_as_float(rr[1]); }
  l_reg = l_reg * alpha + ps;
#define ATT_PK4(P, BASE, OUT) do { unsigned a0 = cvtpk(P[BASE + 0], P[BASE + 1]), a1 = cvtpk(P[BASE + 2], P[BASE + 3]);   \
    unsigned b0 = cvtpk(P[BASE + 4], P[BASE + 5]), b1 = cvtpk(P[BASE + 6], P[BASE + 7]);                              \
    auto r0 = __builtin_amdgcn_permlane32_swap(a0, b0, false, false); auto r1 = __builtin_amdgcn_permlane32_swap(a1, b1, false, false); \
    u32x4 w = {r0[0], r1[0], r0[1], r1[1]}; OUT = *reinterpret_cast<bf16x8*>(&w); } while (0)
  ATT_PK4(p0, 0, pa0); ATT_PK4(p0, 8, pa1); ATT_PK4(p1, 0, pa2); ATT_PK4(p1, 8, pa3);
#undef ATT_PK4
}
template <int KC> __device__ __forceinline__ void qkt(f32x16& p0, f32x16& p1, const char* Ks, const bf16x8* qr, int r32, int hi, int koffB) {
  p0 = f32x16{}; p1 = f32x16{};
#pragma unroll
  for (int d0 = 0; d0 < 4; ++d0) { const int cb = koffB + (d0 * 16 + hi * 8) * 2;
    const bf16x8 b0 = *reinterpret_cast<const bf16x8*>(Ks + kswz<KC>(r32, cb));
    const bf16x8 b1 = *reinterpret_cast<const bf16x8*>(Ks + kswz<KC>(32 + r32, cb));
    p0 = __builtin_amdgcn_mfma_f32_32x32x16_bf16(b0, qr[d0], p0, 0, 0, 0);
    p1 = __builtin_amdgcn_mfma_f32_32x32x16_bf16(b1, qr[d0], p1, 0, 0, 0); }
}
template <int DV, int D0> __device__ __forceinline__ void pv_one(f32x16& od, int vb, bf16x8 pa0, bf16x8 pa1, bf16x8 pa2, bf16x8 pa3) {
  constexpr int KS = (DV / 32) * 1024, HF = (DV / 32) * 512;
  s16x4 l0 = tr_read<D0 * 512 + 0 * KS>(vb), h0 = tr_read<D0 * 512 + 0 * KS + HF>(vb), l1 = tr_read<D0 * 512 + 1 * KS>(vb), h1 = tr_read<D0 * 512 + 1 * KS + HF>(vb);
  s16x4 l2 = tr_read<D0 * 512 + 2 * KS>(vb), h2 = tr_read<D0 * 512 + 2 * KS + HF>(vb), l3 = tr_read<D0 * 512 + 3 * KS>(vb), h3 = tr_read<D0 * 512 + 3 * KS + HF>(vb);
  asm volatile("s_waitcnt lgkmcnt(0)" : "+v"(l0), "+v"(h0), "+v"(l1), "+v"(h1), "+v"(l2), "+v"(h2), "+v"(l3), "+v"(h3) :: "memory");
#define ATT_PKV(L, H) (bf16x8){L[0], L[1], L[2], L[3], H[0], H[1], H[2], H[3]}
  od = __builtin_amdgcn_mfma_f32_32x32x16_bf16(pa0, ATT_PKV(l0, h0), od, 0, 0, 0);
  od = __builtin_amdgcn_mfma_f32_32x32x16_bf16(pa1, ATT_PKV(l1, h1), od, 0, 0, 0);
  od = __builtin_amdgcn_mfma_f32_32x32x16_bf16(pa2, ATT_PKV(l2, h2), od, 0, 0, 0);
  od = __builtin_amdgcn_mfma_f32_32x32x16_bf16(pa3, ATT_PKV(l3, h3), od, 0, 0, 0);
#undef ATT_PKV
}
template <int DV, int D0> __device__ __forceinline__ void pv_pair(f32x16& oa, f32x16& ob, int vb, bf16x8 pa0, bf16x8 pa1, bf16x8 pa2, bf16x8 pa3) {
  constexpr int KS = (DV / 32) * 1024, HF = (DV / 32) * 512, D1 = D0 + 1;
  s16x4 l0 = tr_read<D0 * 512 + 0 * KS>(vb), h0 = tr_read<D0 * 512 + 0 * KS + HF>(vb), l1 = tr_read<D0 * 512 + 1 * KS>(vb), h1 = tr_read<D0 * 512 + 1 * KS + HF>(vb);
  s16x4 l2 = tr_read<D0 * 512 + 2 * KS>(vb), h2 = tr_read<D0 * 512 + 2 * KS + HF>(vb), l3 = tr_read<D0 * 512 + 3 * KS>(vb), h3 = tr_read<D0 * 512 + 3 * KS + HF>(vb);
  s16x4 m0 = tr_read<D1 * 512 + 0 * KS>(vb), n0 = tr_read<D1 * 512 + 0 * KS + HF>(vb), m1 = tr_read<D1 * 512 + 1 * KS>(vb), n1 = tr_read<D1 * 512 + 1 * KS + HF>(vb);
  s16x4 m2 = tr_read<D1 * 512 + 2 * KS>(vb), n2 = tr_read<D1 * 512 + 2 * KS + HF>(vb), m3 = tr_read<D1 * 512 + 3 * KS>(vb), n3 = tr_read<D1 * 512 + 3 * KS + HF>(vb);
  asm volatile("s_waitcnt lgkmcnt(8)" : "+v"(l0), "+v"(h0), "+v"(l1), "+v"(h1), "+v"(l2), "+v"(h2), "+v"(l3), "+v"(h3) :: "memory");
#define ATT_PKV(L, H) (bf16x8){L[0], L[1], L[2], L[3], H[0], H[1], H[2], H[3]}
  oa = __builtin_amdgcn_mfma_f32_32x32x16_bf16(pa0, ATT_PKV(l0, h0), oa, 0, 0, 0); oa = __builtin_amdgcn_mfma_f32_32x32x16_bf16(pa1, ATT_PKV(l1, h1), oa, 0, 0, 0);
  oa = __builtin_amdgcn_mfma_f32_32x32x16_bf16(pa2, ATT_PKV(l2, h2), oa, 0, 0, 0); oa = __builtin_amdgcn_mfma_f32_32x32x16_bf16(pa3, ATT_PKV(l3, h3), oa, 0, 0, 0);
  asm volatile("s_waitcnt lgkmcnt(0)" : "+v"(m0), "+v"(n0), "+v"(m1), "+v"(n1), "+v"(m2), "+v"(n2), "+v"(m3), "+v"(n3) :: "memory");
  ob = __builtin_amdgcn_mfma_f32_32x32x16_bf16(pa0, ATT_PKV(m0, n0), ob, 0, 0, 0); ob = __builtin_amdgcn_mfma_f32_32x32x16_bf16(pa1, ATT_PKV(m1, n1), ob, 0, 0, 0);
  ob = __builtin_amdgcn_mfma_f32_32x32x16_bf16(pa2, ATT_PKV(m2, n2), ob, 0, 0, 0); ob = __builtin_amdgcn_mfma_f32_32x32x16_bf16(pa3, ATT_PKV(m3, n3), ob, 0, 0, 0);
#undef ATT_PKV
}
template <int DV, int D0> __device__ __forceinline__ void pv_one2(f32x16& oa, f32x16& ob, int vb, bf16x8 pa0, bf16x8 pa1, bf16x8 pa2, bf16x8 pa3, bf16x8 pb0, bf16x8 pb1, bf16x8 pb2, bf16x8 pb3) {
  constexpr int KS = (DV / 32) * 1024, HF = (DV / 32) * 512;
  s16x4 l0 = tr_read<D0 * 512 + 0 * KS>(vb), h0 = tr_read<D0 * 512 + 0 * KS + HF>(vb), l1 = tr_read<D0 * 512 + 1 * KS>(vb), h1 = tr_read<D0 * 512 + 1 * KS + HF>(vb);
  s16x4 l2 = tr_read<D0 * 512 + 2 * KS>(vb), h2 = tr_read<D0 * 512 + 2 * KS + HF>(vb), l3 = tr_read<D0 * 512 + 3 * KS>(vb), h3 = tr_read<D0 * 512 + 3 * KS + HF>(vb);
  asm volatile("s_waitcnt lgkmcnt(0)" : "+v"(l0), "+v"(h0), "+v"(l1), "+v"(h1), "+v"(l2), "+v"(h2), "+v"(l3), "+v"(h3) :: "memory");
#define ATT_PKV(L, H) (bf16x8){L[0], L[1], L[2], L[3], H[0], H[1], H[2], H[3]}
  oa = __builtin_amdgcn_mfma_f32_32x32x16_bf16(pa0, ATT_PKV(l0, h0), oa, 0, 0, 0); ob = __builtin_amdgcn_mfma_f32_32x32x16_bf16(pb0, ATT_PKV(l0, h0), ob, 0, 0, 0);
  oa = __builtin_amdgcn_mfma_f32_32x32x16_bf16(pa1, ATT_PKV(l1, h1), oa, 0, 0, 0); ob = __builtin_amdgcn_mfma_f32_32x32x16_bf16(pb1, ATT_PKV(l1, h1), ob, 0, 0, 0);
  oa = __builtin_amdgcn_mfma_f32_32x32x16_bf16(pa2, ATT_PKV(l2, h2), oa, 0, 0, 0); ob = __builtin_amdgcn_mfma_f32_32x32x16_bf16(pb2, ATT_PKV(l2, h2), ob, 0, 0, 0);
  oa = __builtin_amdgcn_mfma_f32_32x32x16_bf16(pa3, ATT_PKV(l3, h3), oa, 0, 0, 0); ob = __builtin_amdgcn_mfma_f32_32x32x16_bf16(pb3, ATT_PKV(l3, h3), ob, 0, 0, 0);
#undef ATT_PKV
}
template <int KC> __device__ __forceinline__ void qkt2(f32x16& a0, f32x16& a1, f32x16& b0, f32x16& b1, const char* Ks, const bf16x8* qa, const bf16x8* qb, int r32, int hi) {
  a0 = f32x16{}; a1 = f32x16{}; b0 = f32x16{}; b1 = f32x16{};
#pragma unroll
  for (int d0 = 0; d0 < 4; ++d0) { const int cb = (d0 * 16 + hi * 8) * 2;
    const bf16x8 k0 = *reinterpret_cast<const bf16x8*>(Ks + kswz<KC>(r32, cb));
    const bf16x8 k1 = *reinterpret_cast<const bf16x8*>(Ks + kswz<KC>(32 + r32, cb));
    a0 = __builtin_amdgcn_mfma_f32_32x32x16_bf16(k0, qa[d0], a0, 0, 0, 0); b0 = __builtin_amdgcn_mfma_f32_32x32x16_bf16(k0, qb[d0], b0, 0, 0, 0);
    a1 = __builtin_amdgcn_mfma_f32_32x32x16_bf16(k1, qa[d0], a1, 0, 0, 0); b1 = __builtin_amdgcn_mfma_f32_32x32x16_bf16(k1, qb[d0], b1, 0, 0, 0); }
}
template <int DV> __device__ __forceinline__ void pv_all(f32x16* o, int vb, bf16x8 pa0, bf16x8 pa1, bf16x8 pa2, bf16x8 pa3) {
  pv_one<DV, 0>(o[0], vb, pa0, pa1, pa2, pa3); pv_one<DV, 1>(o[1], vb, pa0, pa1, pa2, pa3);
  if constexpr (DV == 128) { pv_one<DV, 2>(o[2], vb, pa0, pa1, pa2, pa3); pv_one<DV, 3>(o[3], vb, pa0, pa1, pa2, pa3); }
}

struct DiffParams { const float* lam_p; const float* subln; float lambda_init; };
template <bool DIFF>
__device__ __forceinline__ void attn_unit(char* lds, const bf16* __restrict__ qkv, bf16* __restrict__ obuf, int b, int h, int q0, const float* __restrict__ rel_bias, const float* __restrict__ sink, DiffParams dp, bool fill_tab) {
  constexpr int KC = DIFF ? 128 : 64, DV = DIFF ? 128 : 64, NT = DIFF ? 32 : 6, PW = DIFF ? 2 : 1, NO = DV / 32;
  int tid_ = threadIdx.x; asm volatile("" : "+v"(tid_));
  const int tid = tid_, lane = tid & 63, r32 = lane & 31, hi = lane >> 5; const int wid = __builtin_amdgcn_readfirstlane(tid >> 6);
  const int g = wid & 3, c = wid >> 2;
  const unsigned lds0 = (unsigned)(uintptr_t)lds;
  float* wsf = (float*)(lds + A_WS) + wid * 64; float* li_l = wsf; float* al_l = wsf + 32;
  float* tab = (float*)(lds + A_TAB);
  const long rowbase = (long)b * SEQ;
  const int qrow0 = DIFF ? q0 + 32 * g : q0 + 32 * c;
  const int hq = DIFF ? h : 4 * h + g;
  const int qcol = DIFF ? h * 128 + c * 64 : 1536 + hq * 64;
  const int kcol = DIFF ? 512 + h * 128 : 2048 + h * 64, vcol = DIFF ? 1024 + h * 128 : 2176 + h * 64;
  const int koffB = DIFF ? c * 128 : 0;
  const int kbase = DIFF ? 0 : q0 - 128;
  unsigned kofs[PW], vofs[PW];
#pragma unroll
  for (int i = 0; i < PW; ++i) { const int p = PW * wid + i;
    if constexpr (DIFF) { const int row = 4 * p + (lane >> 4), ch = (lane & 15) ^ (row & 7); kofs[i] = (unsigned)(row * (LDQKV * 2) + ch * 16);
      const int st = 2 * p + (lane >> 5), kk = (st >> 2) * 8 + ((lane >> 2) & 7), k = (kk & ~0xC) | ((kk & 4) << 1) | ((kk & 8) >> 1); vofs[i] = (unsigned)(k * (LDQKV * 2) + ((st & 3) * 32 + (lane & 3) * 8) * 2); }
    else { const int row = 8 * p + (lane >> 3), ch = (lane & 7) ^ (row & 7); kofs[i] = (unsigned)(row * (LDQKV * 2) + ch * 16);
      const int st = 2 * p + (lane >> 5), kk = (st >> 1) * 8 + ((lane >> 2) & 7), k = (kk & ~0xC) | ((kk & 4) << 1) | ((kk & 8) >> 1); vofs[i] = (unsigned)(k * (LDQKV * 2) + ((st & 1) * 32 + (lane & 3) * 8) * 2); } }
  const char* Kg = (const char*)(qkv + rowbase * LDQKV + kcol); const char* Vg = (const char*)(qkv + rowbase * LDQKV + vcol);
#define ATT_KPOS(t) (kbase + 64 * (t))
#define ATT_CLAMP(k) ((k) < 0 ? 0 : ((k) > SEQ - 64 ? SEQ - 64 : (k)))
#define ATT_DMA_K(t) do { const int kl_ = ATT_CLAMP(ATT_KPOS(t)); const char* sb_ = Kg + (long)kl_ * (LDQKV * 2); const unsigned ds_ = lds0 + A_K + ((t) % NSLOT) * SLOT + wid * (PW * 1024); \
    _Pragma("unroll") for (int i_ = 0; i_ < PW; ++i_) glds16(sb_, kofs[i_], (unsigned)__builtin_amdgcn_readfirstlane(ds_ + i_ * 1024)); } while (0)
#define ATT_DMA_V(t) do { const int kl_ = ATT_CLAMP(ATT_KPOS(t)); const char* sb_ = Vg + (long)kl_ * (LDQKV * 2); const unsigned ds_ = lds0 + A_V + ((t) % NSLOT) * SLOT + wid * (PW * 1024); \
    _Pragma("unroll") for (int i_ = 0; i_ < PW; ++i_) glds16(sb_, vofs[i_], (unsigned)__builtin_amdgcn_readfirstlane(ds_ + i_ * 1024)); } while (0)
#define ATT_WAITBAR(N) asm volatile("s_waitcnt vmcnt(" #N ") lgkmcnt(0)\n\ts_barrier" ::: "memory")
  ATT_DMA_K(0); ATT_DMA_V(0); ATT_DMA_K(1);
  if (fill_tab) {
  if constexpr (DIFF) {
    for (int i = tid; i < 4096; i += 512) tab[i] = rel_bias[t5_bucket(i - 2047) * 12 + h] * LOG2E;
  } else {
    for (int i = tid; i < 2048; i += 512) { const int hl = i >> 9, rel = (i & 511) - 256; const bool in = rel >= -128 && rel <= 128;
      tab[i] = in ? rel_bias[t5_bucket(rel) * 12 + 4 + 4 * h + hl] * LOG2E : -1e30f; }
  }
  }
  const float cpos = DIFF ? rel_bias[31 * 12 + h] * LOG2E : 0.f, cneg = DIFF ? rel_bias[15 * 12 + h] * LOG2E : 0.f;
  const int TOFF = DIFF ? 2047 : 256 + g * 512;
  bf16x8 qr[4];
  { const bf16* Qw = qkv + (rowbase + qrow0 + r32) * LDQKV + qcol + hi * 8;
#pragma unroll
    for (int d0 = 0; d0 < 4; ++d0) qr[d0] = *reinterpret_cast<const bf16x8*>(Qw + d0 * 16); }
  float m_reg, l_reg;
  if constexpr (DIFF) { m_reg = -1e30f; l_reg = 0.f; } else { m_reg = sink[hq] * LOG2E; l_reg = 1.f; }
  f32x16 o[NO];
#pragma unroll
  for (int d = 0; d < NO; ++d) o[d] = f32x16{};
  const int vb0 = (int)lds0 + A_V + v_rd_base(lane);
  const char* Kl = lds + A_K;
#define ATT_RESC(a) do { if (__any((a) < 1.f)) { if (hi == 0) al_l[r32] = (a); asm volatile("s_waitcnt lgkmcnt(0)" ::: "memory"); \
    _Pragma("unroll") for (int d_ = 0; d_ < NO; ++d_) _Pragma("unroll") for (int r_ = 0; r_ < 16; ++r_) o[d_][r_] *= al_l[crow(r_, hi)]; } } while (0)
#define ATT_MODE(t, UT, CF, TP) do { const int k0_ = ATT_KPOS(t); \
    if constexpr (DIFF) { const int rmin_ = k0_ - (qrow0 + 31), rmax_ = k0_ + 63 - qrow0; UT = !(rmin_ >= 128 || rmax_ <= -128); CF = rmin_ >= 128 ? cpos : cneg; } \
    else { UT = (k0_ >= 0 && k0_ < SEQ); CF = -1e30f; } \
    TP = tab + (k0_ - (qrow0 + r32) + TOFF + 4 * hi); } while (0)
#define ATT_STEP(T, C0, C1, AC, P0, P1, AP) do { bool ut_; float cf_; const float* tp_; \
    qkt<KC>(C0, C1, Kl + ((T) % NSLOT) * SLOT, qr, r32, hi, koffB); \
    if constexpr (DIFF) { if ((T) + 1 < NT) { ATT_DMA_K((T) + 3); ATT_DMA_V((T) + 2); } } \
    finishSM(P0, P1, AP, l_reg, pa0, pa1, pa2, pa3); \
    ATT_MODE(T, ut_, cf_, tp_); \
    if constexpr (DIFF) { const int vb_ = vb0 + (((T) - 1) % NSLOT) * SLOT; float sc_, of_; \
      if (ut_) sm_pre(C0, C1, tp_); \
      ATT_SBAR(); \
      pv_pair<DV, 0>(o[0], o[1], vb_, pa0, pa1, pa2, pa3); const float pm_ = sm_max(C0, C1); sm_dec(pm_, ut_, cf_, m_reg, AC, sc_, of_); sm_exp<0, 8>(C0, sc_, of_); \
      pv_pair<DV, 2>(o[2], o[3], vb_, pa0, pa1, pa2, pa3); sm_exp<8, 16>(C0, sc_, of_); sm_sub(C1, sc_, of_); \
    } else { ATT_SBAR(); \
      pv_all<DV>(o, vb0 + (((T) - 1) % NSLOT) * SLOT, pa0, pa1, pa2, pa3); \
      partialSM(C0, C1, m_reg, AC, ut_, cf_, tp_); } \
    ATT_RESC(AC); } while (0)
  f32x16 pA0, pA1, pB0, pB1; float alA, alB; bf16x8 pa0, pa1, pa2, pa3;
  ATT_WAITBAR(0);
  ATT_DMA_V(1); ATT_DMA_K(2); ATT_DMA_K(3); ATT_DMA_V(2);
  { bool ut_; float cf_; const float* tp_; qkt<KC>(pA0, pA1, Kl, qr, r32, hi, koffB); ATT_MODE(0, ut_, cf_, tp_); partialSM(pA0, pA1, m_reg, alA, ut_, cf_, tp_); }
  if constexpr (DIFF) ATT_WAITBAR(8); else ATT_WAITBAR(4);
  int t = 1;
  for (; t + 2 < NT; t += 2) {
    if constexpr (!DIFF) { ATT_DMA_K(t + 3); ATT_DMA_V(t + 2); }
    ATT_STEP(t, pB0, pB1, alB, pA0, pA1, alA);
    if constexpr (DIFF) ATT_WAITBAR(8); else ATT_WAITBAR(4);
    if constexpr (!DIFF) { ATT_DMA_K(t + 4); ATT_DMA_V(t + 3); }
    ATT_STEP(t + 1, pA0, pA1, alA, pB0, pB1, alB);
    if constexpr (DIFF) ATT_WAITBAR(8); else ATT_WAITBAR(4);
  }
  ATT_STEP(t, pB0, pB1, alB, pA0, pA1, alA);
  ATT_WAITBAR(0);
  finishSM(pB0, pB1, alB, l_reg, pa0, pa1, pa2, pa3); ATT_SBAR();
  pv_all<DV>(o, vb0 + ((NT - 1) % NSLOT) * SLOT, pa0, pa1, pa2, pa3);
  if (hi == 0) li_l[r32] = l_reg; asm volatile("s_waitcnt lgkmcnt(0)" ::: "memory");
#pragma unroll
  for (int r = 0; r < 16; ++r) { const float rl = __builtin_amdgcn_rcpf(li_l[crow(r, hi)]);
#pragma unroll
    for (int d = 0; d < NO; ++d) o[d][r] *= rl; }
  bf16* Ob = obuf + (rowbase + qrow0) * LDO + (DIFF ? h * 128 : 512 + hq * 64);
  unsigned char* Ob8 = (unsigned char*)obuf + (rowbase + qrow0) * LDO + (DIFF ? h * 128 : 512 + hq * 64);
  if constexpr (DIFF) {
    float s1 = dp.lam_p[lane] * dp.lam_p[64 + lane], s2 = dp.lam_p[128 + lane] * dp.lam_p[192 + lane];
#pragma unroll
    for (int of = 1; of < 64; of <<= 1) { s1 += __shfl_xor(s1, of); s2 += __shfl_xor(s2, of); }
    const float lam = __expf(s1) - __expf(s2) + dp.lambda_init;
    float* xch = (float*)(lds + A_XCH) + g * 4096;
    ATT_WAITBAR(0);
    if (c == 1) {
#pragma unroll
      for (int d = 0; d < NO; ++d)
#pragma unroll
        for (int r = 0; r < 16; ++r) xch[(d * 16 + r) * 64 + lane] = o[d][r] * lam;
    }
    ATT_WAITBAR(0);
    if (c == 0) {
      float gs[NO];
#pragma unroll
      for (int d = 0; d < NO; ++d) gs[d] = dp.subln[32 * d + r32] * (1.0f - dp.lambda_init);
#pragma unroll
      for (int r = 0; r < 16; ++r)
#pragma unroll
        for (int d = 0; d < NO; ++d) o[d][r] -= xch[(d * 16 + r) * 64 + lane];
      asm volatile("s_waitcnt lgkmcnt(0)" ::: "memory");
#pragma unroll
      for (int r = 0; r < 16; ++r) {
        float ss = 0.f;
#pragma unroll
        for (int d = 0; d < NO; ++d) ss += o[d][r] * o[d][r];
#pragma unroll
        for (int of = 1; of < 32; of <<= 1) ss += __shfl_xor(ss, of);
        const float rs = rsqrtf(ss * (1.0f / 128.0f) + 1e-6f);
#pragma unroll
        for (int d = 0; d < NO; ++d) xch[crow(r, hi) * 128 + 32 * d + r32] = o[d][r] * rs * gs[d];
      }
      asm volatile("s_waitcnt lgkmcnt(0)" ::: "memory");
#pragma unroll
      for (int i = 0; i < 4; ++i) { const int row = 8 * i + (lane >> 3), c16 = (lane & 7) * 16; const float* xp = xch + row * 128 + c16;
        const f32x4 u0 = *(const f32x4*)(xp) * pg8::O8_MUL, u1 = *(const f32x4*)(xp + 4) * pg8::O8_MUL, u2 = *(const f32x4*)(xp + 8) * pg8::O8_MUL, u3 = *(const f32x4*)(xp + 12) * pg8::O8_MUL;
        u32x4 w; w.x = pg8::pk4_fp8(u0[0], u0[1], u0[2], u0[3]); w.y = pg8::pk4_fp8(u1[0], u1[1], u1[2], u1[3]); w.z = pg8::pk4_fp8(u2[0], u2[1], u2[2], u2[3]); w.w = pg8::pk4_fp8(u3[0], u3[1], u3[2], u3[3]);
        *(u32x4*)(Ob8 + (long)row * LDO + c16) = w; }
    }
  } else {
#pragma unroll
    for (int r = 0; r < 16; ++r) { bf16* orow = Ob + (long)crow(r, hi) * LDO + r32;
#pragma unroll
      for (int d = 0; d < NO; ++d) orow[32 * d] = (bf16)(cvtpk(o[d][r], 0.f) & 0xffffu); }
  }
  ATT_WAITBAR(0);
#undef ATT_KPOS
#undef ATT_CLAMP
#undef ATT_DMA_K
#undef ATT_DMA_V
#undef ATT_WAITBAR
#undef ATT_RESC
#undef ATT_MODE
#undef ATT_STEP
}

constexpr int W_K = 0, W_V = 6 * 8192;
__device__ __forceinline__ void attn_unit_win2(char* lds, const bf16* __restrict__ qkv, bf16* __restrict__ obuf, int b, int h, int q0, const float* __restrict__ rel_bias, const float* __restrict__ sink, bool fill_tab) {
  constexpr int KC = 64, DV = 64;
  int tid_ = threadIdx.x; asm volatile("" : "+v"(tid_));
  const int tid = tid_, lane = tid & 63, r32 = lane & 31, hi = lane >> 5; const int wid = __builtin_amdgcn_readfirstlane(tid >> 6);
  const int g = wid & 3, rp = wid >> 2, hq = 4 * h + g;
  const unsigned lds0 = (unsigned)(uintptr_t)lds;
  float* wsf = (float*)(lds + A_WS) + wid * 64; float* li_l = wsf; float* al_l = wsf + 32;
  float* tab = (float*)(lds + A_TAB);
  const long rowbase = (long)b * SEQ;
  const int kbase = q0 - 128;
  const char* Kg = (const char*)(qkv + rowbase * LDQKV + 2048 + h * 64); const char* Vg = (const char*)(qkv + rowbase * LDQKV + 2176 + h * 64);
#pragma unroll
  for (int i = 0; i < 6; ++i) { const int pi = wid + 8 * i, tile = pi >> 3, pc = pi & 7; const int k0 = kbase + 64 * tile;
    if (k0 >= 0 && k0 < SEQ) {
      const int row = 8 * pc + (lane >> 3), ch = (lane & 7) ^ (row & 7);
      glds16(Kg + (long)k0 * (LDQKV * 2), (unsigned)(row * (LDQKV * 2) + ch * 16), (unsigned)__builtin_amdgcn_readfirstlane(lds0 + W_K + tile * 8192 + pc * 1024));
      const int st = 2 * pc + (lane >> 5), kk = (st >> 1) * 8 + ((lane >> 2) & 7), k = (kk & ~0xC) | ((kk & 4) << 1) | ((kk & 8) >> 1);
      glds16(Vg + (long)k0 * (LDQKV * 2), (unsigned)(k * (LDQKV * 2) + ((st & 1) * 32 + (lane & 3) * 8) * 2), (unsigned)__builtin_amdgcn_readfirstlane(lds0 + W_V + tile * 8192 + pc * 1024)); } }
  if (fill_tab) {
    for (int i = tid; i < 2048; i += 512) { const int hl = i >> 9, rel = (i & 511) - 256; const bool in = rel >= -128 && rel <= 128;
      tab[i] = in ? rel_bias[t5_bucket(rel) * 12 + 4 + 4 * h + hl] * LOG2E : -1e30f; } }
  const int qrowA = q0 + 64 * rp, qrowB = qrowA + 32;
  bf16x8 qa[4], qb[4];
  { const bf16* Qw = qkv + (rowbase + qrowA + r32) * LDQKV + 1536 + hq * 64 + hi * 8;
#pragma unroll
    for (int d0 = 0; d0 < 4; ++d0) { qa[d0] = *reinterpret_cast<const bf16x8*>(Qw + d0 * 16); qb[d0] = *reinterpret_cast<const bf16x8*>(Qw + 32 * LDQKV + d0 * 16); } }
  const float m0 = sink[hq] * LOG2E;
  float mA = m0, lA = 1.f, mB = m0, lB = 1.f;
  f32x16 oA[2], oB[2];
#pragma unroll
  for (int d = 0; d < 2; ++d) { oA[d] = f32x16{}; oB[d] = f32x16{}; }
  asm volatile("s_waitcnt vmcnt(0) lgkmcnt(0)\n\ts_barrier" ::: "memory");
  const int t0 = rp;
  const float* tpb = tab + g * 512 + 256 + 4 * hi - r32;
#define ATW_RESC(O, a) do { if (__any((a) < 1.f)) { if (hi == 0) al_l[r32] = (a); asm volatile("s_waitcnt lgkmcnt(0)" ::: "memory"); \
    _Pragma("unroll") for (int d_ = 0; d_ < 2; ++d_) _Pragma("unroll") for (int r_ = 0; r_ < 16; ++r_) O[d_][r_] *= al_l[crow(r_, hi)]; asm volatile("s_waitcnt lgkmcnt(0)" ::: "memory"); } } while (0)
#pragma unroll 1
  for (int tt = 0; tt < 5; ++tt) {
    const int t = t0 + tt, k0 = kbase + 64 * t;
    if (k0 < 0 || k0 >= SEQ) continue;
    const char* Ks = lds + W_K + t * 8192; const int vb = (int)lds0 + W_V + t * 8192 + v_rd_base(lane);
    f32x16 a0, a1, b0, b1; float alA, alB, sc, of; bf16x8 pa0, pa1, pa2, pa3, pb0, pb1, pb2, pb3;
    qkt2<KC>(a0, a1, b0, b1, Ks, qa, qb, r32, hi);
    sm_pre(a0, a1, tpb + (k0 - qrowA));
    { const float pm = sm_max(a0, a1); sm_dec(pm, true, 0.f, mA, alA, sc, of); sm_exp<0, 16>(a0, sc, of); sm_sub(a1, sc, of); finishSM(a0, a1, alA, lA, pa0, pa1, pa2, pa3); }
    sm_pre(b0, b1, tpb + (k0 - qrowB));
    { const float pm = sm_max(b0, b1); sm_dec(pm, true, 0.f, mB, alB, sc, of); sm_exp<0, 16>(b0, sc, of); sm_sub(b1, sc, of); finishSM(b0, b1, alB, lB, pb0, pb1, pb2, pb3); }
    ATW_RESC(oA, alA); ATW_RESC(oB, alB);
    ATT_SBAR();
    pv_one2<DV, 0>(oA[0], oB[0], vb, pa0, pa1, pa2, pa3, pb0, pb1, pb2, pb3); pv_one2<DV, 1>(oA[1], oB[1], vb, pa0, pa1, pa2, pa3, pb0, pb1, pb2, pb3);
  }
#undef ATW_RESC
  if (hi == 0) { li_l[r32] = lA; al_l[r32] = lB; }
  asm volatile("s_waitcnt lgkmcnt(0)\n\ts_barrier" ::: "memory");
  float* stg = (float*)(lds + W_K) + wid * 2048;
  unsigned char* Ob8 = (unsigned char*)obuf + (rowbase + qrowA) * LDO + 512 + hq * 64;
#pragma unroll
  for (int task = 0; task < 2; ++task) {
#pragma unroll
    for (int r = 0; r < 16; ++r) { const float rl = __builtin_amdgcn_rcpf(task == 0 ? li_l[crow(r, hi)] : al_l[crow(r, hi)]);
#pragma unroll
      for (int d = 0; d < 2; ++d) stg[crow(r, hi) * 64 + 32 * d + r32] = (task == 0 ? oA[d][r] : oB[d][r]) * rl; }
    asm volatile("s_waitcnt lgkmcnt(0)" ::: "memory");
#pragma unroll
    for (int i = 0; i < 2; ++i) { const int row = 16 * i + (lane >> 2), c16 = (lane & 3) * 16; const float* xp = stg + row * 64 + c16;
      const f32x4 u0 = *(const f32x4*)(xp) * pg8::O8_MUL, u1 = *(const f32x4*)(xp + 4) * pg8::O8_MUL, u2 = *(const f32x4*)(xp + 8) * pg8::O8_MUL, u3 = *(const f32x4*)(xp + 12) * pg8::O8_MUL;
      u32x4 w; w.x = pg8::pk4_fp8(u0[0], u0[1], u0[2], u0[3]); w.y = pg8::pk4_fp8(u1[0], u1[1], u1[2], u1[3]); w.z = pg8::pk4_fp8(u2[0], u2[1], u2[2], u2[3]); w.w = pg8::pk4_fp8(u3[0], u3[1], u3[2], u3[3]);
      *(u32x4*)(Ob8 + (long)(32 * task + row) * LDO + c16) = w; }
    asm volatile("s_waitcnt lgkmcnt(0)" ::: "memory");
  }
  asm volatile("s_waitcnt vmcnt(0) lgkmcnt(0)\n\ts_barrier" ::: "memory");
}
constexpr int A_HX = A_END, A_AL = A_HX + 4 * 2 * 4096, A_FL = A_AL + 4 * 2 * 128, A_LI = A_FL + 64, A_END2 = A_LI + 4 * 128;
__device__ __forceinline__ void attn_unit_diff_split(char* lds, const bf16* __restrict__ qkv, bf16* __restrict__ obuf, int b, int h, int q0, const float* __restrict__ rel_bias, DiffParams dp, bool fill_tab) {
  constexpr int KC = 128, DV = 128, NT = 32, PW = 2, NO = 4;
  int tid_ = threadIdx.x; asm volatile("" : "+v"(tid_));
  const int tid = tid_, lane = tid & 63, r32 = lane & 31, hi = lane >> 5; const int wid = __builtin_amdgcn_readfirstlane(tid >> 6);
  const bool is_s = wid < 4; const int p = wid & 3, rg = p & 1, c = p >> 1;
  const unsigned lds0 = (unsigned)(uintptr_t)lds;
  float* tab = (float*)(lds + A_TAB);
  const long rowbase = (long)b * SEQ;
  const int qrow0 = q0 + 32 * rg;
  const int qcol = h * 128 + c * 64, kcol = 512 + h * 128, vcol = 1024 + h * 128, koffB = c * 128;
  unsigned kofs[PW], vofs[PW];
#pragma unroll
  for (int i = 0; i < PW; ++i) { const int pc = PW * wid + i;
    const int row = 4 * pc + (lane >> 4), ch = (lane & 15) ^ (row & 7); kofs[i] = (unsigned)(row * (LDQKV * 2) + ch * 16);
    const int st = 2 * pc + (lane >> 5), kk = (st >> 2) * 8 + ((lane >> 2) & 7), k = (kk & ~0xC) | ((kk & 4) << 1) | ((kk & 8) >> 1); vofs[i] = (unsigned)(k * (LDQKV * 2) + ((st & 3) * 32 + (lane & 3) * 8) * 2); }
  const char* Kg = (const char*)(qkv + rowbase * LDQKV + kcol); const char* Vg = (const char*)(qkv + rowbase * LDQKV + vcol);
#define ATS_DMA_K(t) do { const char* sb_ = Kg + (long)(64 * (t)) * (LDQKV * 2); const unsigned ds_ = lds0 + A_K + ((t) % NSLOT) * SLOT + wid * (PW * 1024); \
    _Pragma("unroll") for (int i_ = 0; i_ < PW; ++i_) glds16(sb_, kofs[i_], (unsigned)__builtin_amdgcn_readfirstlane(ds_ + i_ * 1024)); } while (0)
#define ATS_DMA_V(t) do { const char* sb_ = Vg + (long)(64 * (t)) * (LDQKV * 2); const unsigned ds_ = lds0 + A_V + ((t) % NSLOT) * SLOT + wid * (PW * 1024); \
    _Pragma("unroll") for (int i_ = 0; i_ < PW; ++i_) glds16(sb_, vofs[i_], (unsigned)__builtin_amdgcn_readfirstlane(ds_ + i_ * 1024)); } while (0)
#define ATS_WAITBAR(N) asm volatile("s_waitcnt vmcnt(" #N ") lgkmcnt(0)\n\ts_barrier" ::: "memory")
  ATS_DMA_K(0); ATS_DMA_V(0); ATS_DMA_K(1);
  if (fill_tab) { for (int i = tid; i < 4096; i += 512) tab[i] = rel_bias[t5_bucket(i - 2047) * 12 + h] * LOG2E; }
  const float cpos = rel_bias[31 * 12 + h] * LOG2E, cneg = rel_bias[15 * 12 + h] * LOG2E;
  char* hx = lds + A_HX + p * 8192; float* alx = (float*)(lds + A_AL) + p * 64; unsigned* flx = (unsigned*)(lds + A_FL) + p * 2; float* lix = (float*)(lds + A_LI) + p * 32;
  const char* Kl = lds + A_K;
#define ATS_HAND(T, AP, F0, F1, F2, F3) do { char* hs_ = hx + ((T) & 1) * 4096 + lane * 16; \
    *(bf16x8*)(hs_) = F0; *(bf16x8*)(hs_ + 1024) = F1; *(bf16x8*)(hs_ + 2048) = F2; *(bf16x8*)(hs_ + 3072) = F3; \
    if (hi == 0) alx[((T) & 1) * 32 + r32] = (AP); \
    const bool any_ = __any((AP) < 1.f); if (lane == 0) flx[(T) & 1] = any_ ? 1u : 0u; } while (0)
#define ATS_MODE(T, UT, CF, TP) do { const int k0_ = 64 * (T); const int rmin_ = k0_ - (qrow0 + 31), rmax_ = k0_ + 63 - qrow0; UT = !(rmin_ >= 128 || rmax_ <= -128); CF = rmin_ >= 128 ? cpos : cneg; \
    TP = tab + (k0_ - (qrow0 + r32) + 2047 + 4 * hi); } while (0)
#define ATS_STEP(T, C0, C1, AC, P0, P1, AP) do { bool ut_; float cf_; const float* tp_; bf16x8 f0_, f1_, f2_, f3_; \
    qkt<KC>(C0, C1, Kl + ((T) % NSLOT) * SLOT, qr, r32, hi, koffB); \
    finishSM(P0, P1, AP, l_reg, f0_, f1_, f2_, f3_); \
    ATS_HAND((T) - 1, AP, f0_, f1_, f2_, f3_); \
    ATS_MODE(T, ut_, cf_, tp_); partialSM(C0, C1, m_reg, AC, ut_, cf_, tp_); } while (0)
#define ATS_PV(T) do { const float* as_ = alx + ((T) & 1) * 32; \
    if (flx[(T) & 1] != 0u) { _Pragma("unroll") for (int d_ = 0; d_ < NO; ++d_) _Pragma("unroll") for (int r_ = 0; r_ < 16; ++r_) o[d_][r_] *= as_[crow(r_, hi)]; } \
    const char* hs_ = hx + ((T) & 1) * 4096 + lane * 16; \
    const bf16x8 f0_ = *(const bf16x8*)(hs_), f1_ = *(const bf16x8*)(hs_ + 1024), f2_ = *(const bf16x8*)(hs_ + 2048), f3_ = *(const bf16x8*)(hs_ + 3072); \
    pv_all<DV>(o, vb0 + ((T) % NSLOT) * SLOT, f0_, f1_, f2_, f3_); } while (0)
  ATS_WAITBAR(0);
  if (is_s) {
    bf16x8 qr[4]; float m_reg = -1e30f, l_reg = 0.f;
    { const bf16* Qw = qkv + (rowbase + qrow0 + r32) * LDQKV + qcol + hi * 8;
#pragma unroll
      for (int d0 = 0; d0 < 4; ++d0) qr[d0] = *reinterpret_cast<const bf16x8*>(Qw + d0 * 16); }
    f32x16 pA0, pA1, pB0, pB1; float alA = 1.f, alB = 1.f;
    ATS_DMA_K(2);
    { bool ut_; float cf_; const float* tp_; qkt<KC>(pA0, pA1, Kl, qr, r32, hi, koffB); ATS_MODE(0, ut_, cf_, tp_); partialSM(pA0, pA1, m_reg, alA, ut_, cf_, tp_); }
    ATS_WAITBAR(2);
    ATS_DMA_K(3); ATS_DMA_V(1);
    ATS_STEP(1, pB0, pB1, alB, pA0, pA1, alA);
    ATS_WAITBAR(4);
    int t = 2;
    for (; t + 2 < NT; t += 2) {
      ATS_DMA_K(t + 2); ATS_DMA_V(t); ATS_STEP(t, pA0, pA1, alA, pB0, pB1, alB); ATS_WAITBAR(4);
      ATS_DMA_K(t + 3); ATS_DMA_V(t + 1); ATS_STEP(t + 1, pB0, pB1, alB, pA0, pA1, alA); ATS_WAITBAR(4);
    }
    ATS_DMA_V(t); ATS_STEP(t, pA0, pA1, alA, pB0, pB1, alB); ATS_WAITBAR(2);
    ATS_DMA_V(t + 1); ATS_STEP(t + 1, pB0, pB1, alB, pA0, pA1, alA); ATS_WAITBAR(2);
    { bf16x8 f0_, f1_, f2_, f3_; finishSM(pB0, pB1, alB, l_reg, f0_, f1_, f2_, f3_); ATS_HAND(NT - 1, alB, f0_, f1_, f2_, f3_); if (hi == 0) lix[r32] = l_reg; }
    ATS_WAITBAR(0);
    ATS_WAITBAR(0);
    ATS_WAITBAR(0);
    ATS_WAITBAR(0);
  } else {
    f32x16 o[NO];
#pragma unroll
    for (int d = 0; d < NO; ++d) o[d] = f32x16{};
    const int vb0 = (int)lds0 + A_V + v_rd_base(lane);
    ATS_DMA_K(2); ATS_WAITBAR(2);
    ATS_DMA_K(3); ATS_DMA_V(1); ATS_WAITBAR(4);
    int t = 2;
    for (; t + 2 < NT; t += 2) {
      ATS_DMA_K(t + 2); ATS_DMA_V(t); ATS_PV(t - 2); ATS_WAITBAR(4);
      ATS_DMA_K(t + 3); ATS_DMA_V(t + 1); ATS_PV(t - 1); ATS_WAITBAR(4);
    }
    ATS_DMA_V(t); ATS_PV(t - 2); ATS_WAITBAR(2);
    ATS_DMA_V(t + 1); ATS_PV(t - 1); ATS_WAITBAR(2);
    ATS_PV(NT - 2); ATS_WAITBAR(0);
    ATS_PV(NT - 1); ATS_WAITBAR(0);
    float lam;
    { float s1 = dp.lam_p[lane] * dp.lam_p[64 + lane], s2 = dp.lam_p[128 + lane] * dp.lam_p[192 + lane];
#pragma unroll
      for (int of = 1; of < 64; of <<= 1) { s1 += __shfl_xor(s1, of); s2 += __shfl_xor(s2, of); }
      lam = __expf(s1) - __expf(s2) + dp.lambda_init; }
    float* xch = (float*)(lds + A_XCH) + rg * 4096;
#pragma unroll
    for (int r = 0; r < 16; ++r) { const float rl = __builtin_amdgcn_rcpf(lix[crow(r, hi)]);
#pragma unroll
      for (int d = 0; d < NO; ++d) o[d][r] *= rl; }
    if (c == 1) {
#pragma unroll
      for (int d = 0; d < NO; ++d)
#pragma unroll
        for (int r = 0; r < 16; ++r) xch[(d * 16 + r) * 64 + lane] = o[d][r] * lam;
    }
    ATS_WAITBAR(0);
    if (c == 0) {
      bf16* Ob = obuf + (rowbase + qrow0) * LDO + h * 128;
      float gs[NO];
#pragma unroll
      for (int d = 0; d < NO; ++d) gs[d] = dp.subln[32 * d + r32] * (1.0f - dp.lambda_init);
#pragma unroll
      for (int r = 0; r < 16; ++r) {
        float ss = 0.f;
#pragma unroll
        for (int d = 0; d < NO; ++d) { o[d][r] -= xch[(d * 16 + r) * 64 + lane]; ss += o[d][r] * o[d][r]; }
#pragma unroll
        for (int of = 1; of < 32; of <<= 1) ss += __shfl_xor(ss, of);
        const float rs = rsqrtf(ss * (1.0f / 128.0f) + 1e-6f);
        bf16* orow = Ob + (long)crow(r, hi) * LDO + r32;
#pragma unroll
        for (int d = 0; d < NO; ++d) orow[32 * d] = (bf16)(cvtpk(o[d][r] * rs * gs[d], 0.f) & 0xffffu);
      }
    }
    ATS_WAITBAR(0);
  }
#undef ATS_DMA_K
#undef ATS_DMA_V
#undef ATS_WAITBAR
#undef ATS_HAND
#undef ATS_MODE
#undef ATS_STEP
#undef ATS_PV
}
#undef ATT_SBAR
}

#ifndef PH_MASK
#define PH_MASK 0xFFFF
#endif
#define PH(k) ((PH_MASK >> (k)) & 1)
#ifndef REP_MASK
#define REP_MASK 0
#endif
#define REPS(k) (1 + ((REP_MASK >> (k)) & 1))
constexpr int NWAVES = 8;
constexpr int NBATCH = 16, SEQ = 2048, DM = 1024, NTOK = NBATCH * SEQ, DEPTH = 2;
constexpr int INC = 4352, QKVC = 2304, GATEC = 2048, NEXP = 32, FH = 512;
constexpr float RMS_EPS = 1e-6f;
#ifndef P1_F8_QKV
#define P1_F8_QKV 0x1FFu
#endif
constexpr unsigned P1_F8_TILES = 0x1FE00u | P1_F8_QKV, P1_B16_TILES = 0x1FFu & ~P1_F8_QKV;
constexpr int P1_NF8 = __builtin_popcount(P1_F8_TILES), P1_NB16 = __builtin_popcount(P1_B16_TILES);
constexpr size_t MiB = 1u << 20;
constexpr size_t WS_CTL = 0, CTL_ZERO_BYTES = 1 * MiB;
constexpr size_t WS_TOK = 2 * MiB;
constexpr size_t WS_RS = 3 * MiB;
constexpr size_t WS_WIN = 4 * MiB;
constexpr size_t WS_PT = 21 * MiB;
constexpr size_t WS_WO = 25 * MiB;
constexpr size_t WS_RTW = 29 * MiB;
constexpr size_t WS_WGU = 32 * MiB;
constexpr size_t WS_WD = 64 * MiB;
constexpr size_t WS_H8 = 80 * MiB;
constexpr size_t WS_WG8 = 112 * MiB;
constexpr size_t WS_H = 128 * MiB;
constexpr size_t WS_QKV = 192 * MiB;
constexpr size_t WS_GATES = 336 * MiB;
constexpr size_t WS_WGU1 = 400 * MiB, WS_WD1 = 432 * MiB;
constexpr size_t WS_O = 464 * MiB;
constexpr size_t WS_LIST = 528 * MiB;
constexpr size_t WS_END = 532 * MiB;
constexpr int RMAX_TILES = 288;
#ifndef FILL_P1
#define FILL_P1 4
#endif
#ifndef FILL_P6
#define FILL_P6 2
#endif
#ifndef FILL_P7
#define FILL_P7 1
#endif
constexpr int CW_BAR = 4096;
constexpr int CW_CNT = 8192;
constexpr int LDS_SCRATCH = 155648;
constexpr int LDS_MISC = LDS_SCRATCH;
constexpr int LDS_BYTES = 163840;
constexpr int MW_PAD = 16, MW_NT = 50, MW_TILE = 64, MW_CNT = 360, MW_ROW = 512, ROWTAB_UNITS = 6;

#define GAS __attribute__((address_space(1)))
#define LAS __attribute__((address_space(3)))
typedef unsigned short bf16;
typedef unsigned v4u __attribute__((ext_vector_type(4)));
typedef unsigned v2u __attribute__((ext_vector_type(2)));
typedef float f32x4 __attribute__((ext_vector_type(4)));
#define RLX_AGENT __ATOMIC_RELAXED, __HIP_MEMORY_SCOPE_AGENT
#define LDS_WAIT() asm volatile("s_waitcnt lgkmcnt(0)" ::: "memory")
__device__ __forceinline__ unsigned f2bf(float f) { unsigned u = __builtin_bit_cast(unsigned, f); return (u + 0x7fffu + ((u >> 16) & 1u)) >> 16; }
__device__ __forceinline__ unsigned pk2(float lo, float hi) { return f2bf(lo) | (f2bf(hi) << 16); }
__device__ __forceinline__ float bflo(unsigned w) { return __uint_as_float(w << 16); }
__device__ __forceinline__ float bfhi(unsigned w) { return __uint_as_float(w & 0xffff0000u); }
typedef float f32x2v __attribute__((ext_vector_type(2)));
__device__ __forceinline__ f32x4 fp8x4_to_f32(unsigned w) { const f32x2v lo = __builtin_amdgcn_cvt_pk_f32_fp8((int)w, false), hi = __builtin_amdgcn_cvt_pk_f32_fp8((int)w, true); return (f32x4){lo.x, lo.y, hi.x, hi.y}; }
__device__ __forceinline__ float wave_sum(float v) {
#pragma unroll
    for (int o = 1; o < 64; o <<= 1) v += __shfl_xor(v, o);
    return v;
}

#define XB_TMO      128
#define XB_XCNT(j)  (256  + 64 * (j))
#define XB_XSUB(j)  (1280 + 64 * (j))
#define XB_XGEN(j)  (2304 + 64 * (j))
#define XB_TOP      3328
#define XB_TOPGEN   3392
#define XCD_BAR_WORDS 3456
#define XB_SPIN_CAP (1u << 18)

__device__ __forceinline__ unsigned xb_ld(unsigned* p)              { return __hip_atomic_load(p, __ATOMIC_RELAXED, __HIP_MEMORY_SCOPE_AGENT); }
__device__ __forceinline__ unsigned xb_add(unsigned* p, unsigned v) { return __hip_atomic_fetch_add(p, v, __ATOMIC_RELAXED, __HIP_MEMORY_SCOPE_AGENT); }
__device__ __forceinline__ unsigned xb_xcc_id() { return (unsigned)__builtin_amdgcn_s_getreg((3 << 11) | 20) & 0xFu; }
#define XB_SPIN(cond, bar) do { unsigned _sp = 0; while (cond) { __builtin_amdgcn_s_sleep(1); \
    if ((++_sp & 255u) == 0u) { if (xb_ld(&(bar)[XB_TMO])) break; if (_sp > XB_SPIN_CAP) { atomicAdd(&(bar)[XB_TMO], 1u); break; } } } } while (0)

struct XcdBarrier {
    unsigned* bar; unsigned x;
    volatile LAS unsigned* st;
};

__device__ __forceinline__ XcdBarrier xcd_barrier_post(unsigned* bar, volatile LAS unsigned* st) {
    XcdBarrier b; b.bar = bar; b.x = xb_xcc_id(); b.st = st;
    if (threadIdx.x == 0) (void)xb_add(&bar[XB_XCNT(b.x)], 1u);
    return b;
}
__device__ __forceinline__ void xcd_barrier_complete(unsigned* bar, unsigned x, unsigned& nloc, unsigned& nx) {
    const unsigned G = gridDim.x * gridDim.y * gridDim.z;
    unsigned sum, cnt, mine, sp = 0u;
    for (;;) {
        sum = 0u; cnt = 0u; mine = 0u;
#pragma unroll
        for (unsigned j = 0; j < 16; ++j) { const unsigned c = xb_ld(&bar[XB_XCNT(j)]); sum += c; cnt += (c > 0u) ? 1u : 0u; mine = (j == x) ? c : mine; }
        if (sum == G) break;
        __builtin_amdgcn_s_sleep(1);
        if ((++sp & 255u) == 0u) { if (xb_ld(&bar[XB_TMO])) break; if (sp > XB_SPIN_CAP) { atomicAdd(&bar[XB_TMO], 1u); break; } }
    }
    nloc = mine > 0u ? mine : 1u; nx = cnt > 0u ? cnt : 1u;
}

__device__ __forceinline__ void xcd_barrier(const XcdBarrier& b) {
    asm volatile("s_waitcnt vmcnt(0)" ::: "memory");
    __syncthreads();
    if (threadIdx.x == 0) {
        unsigned* bar = b.bar;
        __builtin_amdgcn_s_waitcnt(0);
        unsigned nloc = b.st[0], nx = b.st[1];
        if (nloc == 0u) { xcd_barrier_complete(bar, b.x, nloc, nx); b.st[0] = nloc; b.st[1] = nx; }
        const unsigned old = xb_add(&bar[XB_XSUB(b.x)], 1u);
        const unsigned gen = old / nloc;
        if (old + 1u == (gen + 1u) * nloc) {
            __builtin_amdgcn_fence(__ATOMIC_RELEASE, "agent");
            asm volatile("s_waitcnt vmcnt(0)" ::: "memory");
            const unsigned og = xb_add(&bar[XB_TOP], 1u);
            const unsigned tg = og / nx;
            if (og + 1u == (tg + 1u) * nx) xb_add(&bar[XB_TOPGEN], 1u);
            else XB_SPIN(xb_ld(&bar[XB_TOPGEN]) == tg, bar);
            __builtin_amdgcn_fence(__ATOMIC_ACQUIRE, "agent");
            xb_add(&bar[XB_XGEN(b.x)], 1u);
            asm volatile("s_waitcnt vmcnt(0)" ::: "memory");
        } else {
            XB_SPIN(xb_ld(&bar[XB_XGEN(b.x)]) == gen, bar);
            __builtin_amdgcn_fence(__ATOMIC_ACQUIRE, "agent");
            asm volatile("s_waitcnt vmcnt(0)" ::: "memory");
        }
    }
    __syncthreads();
}


constexpr int TR_SCR = 16896;
template <bool FP8 = false> __device__ __forceinline__ void transpose_item(const float* W, int K, int N, bf16* WT, int ldt, int mode, LAS float* scr, int item, int lane, float mul = 1.f, const float* rg = nullptr) {
    const int nblk = N / 64, kb = item / nblk, nb = item % nblk, k0 = 64 * kb, n0 = 64 * nb;
    const int vrow0 = mode == 0 ? n0 : ((n0 >> 7) * 256 + (n0 & 127) + (mode == 2 ? 128 : 0));
    const int kr = lane >> 4, nq = (lane & 15) * 4;
    f32x4 v[16];
#pragma unroll
    for (int i = 0; i < 16; ++i) v[i] = *(const GAS f32x4*)(W + (size_t)(k0 + 4 * i + kr) * N + n0 + nq);
    if (rg) {
#pragma unroll
        for (int i = 0; i < 16; ++i) v[i] *= rg[k0 + 4 * i + kr]; }
#pragma unroll
    for (int i = 0; i < 16; ++i) { LAS float* d = scr + (4 * i + kr) * 65 + nq; d[0] = v[i].x; d[1] = v[i].y; d[2] = v[i].z; d[3] = v[i].w; }
    LDS_WAIT(); asm volatile("" ::: "memory");
    const int c = lane & 7;
#pragma unroll
    for (int j = 0; j < 8; ++j) { const int n = (lane >> 3) + 8 * j; const LAS float* s = scr + (8 * c) * 65 + n;
        if constexpr (FP8) { v2u o; o.x = pg8::pk4_fp8(mul * s[0 * 65], mul * s[1 * 65], mul * s[2 * 65], mul * s[3 * 65]); o.y = pg8::pk4_fp8(mul * s[4 * 65], mul * s[5 * 65], mul * s[6 * 65], mul * s[7 * 65]);
            *(GAS v2u*)((unsigned char*)WT + (size_t)(vrow0 + n) * ldt + k0 + 8 * c) = o; }
        else { v4u o; o.x = pk2(s[0 * 65], s[1 * 65]); o.y = pk2(s[2 * 65], s[3 * 65]); o.z = pk2(s[4 * 65], s[5 * 65]); o.w = pk2(s[6 * 65], s[7 * 65]);
            *(GAS v4u*)(WT + (size_t)(vrow0 + n) * ldt + k0 + 8 * c) = o; } }
    LDS_WAIT(); asm volatile("" ::: "memory");
}
__device__ __forceinline__ void cvt_small_weights(const float* w_in, const float* norm_mix, const float* w_bd, const float* w_bw, const float* w_out, unsigned char* ws, LAS float* scr, int gw, int ngw, int lane) {
    constexpr int I_IN = 16 * 68, I_B = 8 * 16, I_O = 16 * 16, I_L = I_IN + 2 * I_B + I_O;
    for (int it = gw; it < 2 * I_L; it += ngw) {
        const int l = it / I_L; int r = it % I_L;
        if (r < I_IN) { if (!((P1_F8_TILES >> ((r % 68) >> 2)) & 1u)) transpose_item(w_in + (size_t)l * DM * INC, DM, INC, (bf16*)(ws + WS_WIN) + (size_t)l * INC * DM, DM, 0, scr, r, lane, 1.f, norm_mix + l * DM);
            else transpose_item<true>(w_in + (size_t)l * DM * INC, DM, INC, (bf16*)(ws + WS_WG8 + (size_t)l * INC * DM), DM, 0, scr, r, lane, pg8::WGU8_MUL, norm_mix + l * DM);
            continue; } r -= I_IN;
        if (r < I_B) { transpose_item<true>(w_bd + (size_t)l * 512 * DM, 512, DM, (bf16*)(ws + WS_PT + (size_t)l * DM * DM), DM, 0, scr, r, lane, pg8::PT8_MUL); continue; } r -= I_B;
        if (r < I_B) { transpose_item<true>(w_bw + (size_t)l * 512 * DM, 512, DM, (bf16*)(ws + WS_PT + (size_t)l * DM * DM + 512), DM, 0, scr, r, lane, pg8::PT8_MUL); continue; } r -= I_B;
        transpose_item<true>(w_out + (size_t)l * DM * DM, DM, DM, (bf16*)(ws + WS_WO + (size_t)l * DM * DM), DM, 0, scr, r, lane, pg8::WO8_MUL);
    }
}
__device__ __forceinline__ void cvt_expert_item(const float* wg, const float* wu, const float* wd, int l, unsigned char* wgu, unsigned char* wdn, LAS float* scr, int it, int lane) {
    int e, r; if (it < NEXP * 256) { e = it >> 8; r = it & 255; } else { const int jj = it - NEXP * 256; e = jj >> 7; r = 256 + (jj & 127); }
    const int which = r >> 7, item = r & 127;
    const size_t eo = (size_t)(l * NEXP + e) * DM * FH;
    if (which == 0) transpose_item<true>(wg + eo, DM, FH, (bf16*)(wgu + (size_t)e * 1024 * DM), DM, 1, scr, item, lane, pg8::WGU8_MUL);
    else if (which == 1) transpose_item<true>(wu + eo, DM, FH, (bf16*)(wgu + (size_t)e * 1024 * DM), DM, 2, scr, item, lane, pg8::WGU8_MUL);
    else transpose_item<true>(wd + eo, FH, DM, (bf16*)(wdn + (size_t)e * DM * FH), FH, 0, scr, item, lane, pg8::WD8_MUL);
}
__device__ __forceinline__ void cvt_expert_weights(const float* wg, const float* wu, const float* wd, int l, unsigned char* ws, LAS float* scr, int gw, int ngw, int lane, int first) {
    for (int it = first + gw; it < NEXP * 384; it += ngw) cvt_expert_item(wg, wu, wd, l, ws + WS_WGU, ws + WS_WD, scr, it, lane);
}
__device__ __forceinline__ void cvt_fill_slots(const float* wg, const float* wu, const float* wd, unsigned char* ws, LAS float* scr, int base, int kstride, int slot, int budget, int lane, int lay = 1) {
    for (int k = 0; k < budget; ++k) { const int it = base + k * kstride + slot; if (it < NEXP * 384) cvt_expert_item(wg, wu, wd, lay, ws + (lay ? WS_WGU1 : WS_WGU), ws + (lay ? WS_WD1 : WS_WD), scr, it, lane); }
}
__device__ __forceinline__ void cvt_leftover(const float* wg, const float* wu, const float* wd, unsigned char* ws, LAS float* scr, int G, int nun0, int first, int stride, int lane, bool down) {
    const int r = nun0 % G, nshort = r ? G - r : 0, nhole = (G - nshort) * 8;
    const int base6 = FILL_P1 * (G / 2) * 8, base7 = base6 + FILL_P6 * G * 8, base8 = base7 + FILL_P7 * G * 8;
    const int n6 = FILL_P6 * nhole, n7 = FILL_P7 * nhole, nrest = NEXP * 384 > base8 ? NEXP * 384 - base8 : 0;
    for (int h = first; h < n6 + n7 + nrest; h += stride) {
        int it; if (h < n6) it = base6 + (h / nhole) * G * 8 + nshort * 8 + h % nhole; else if (h < n6 + n7) { const int hh = h - n6; it = base7 + (hh / nhole) * G * 8 + nshort * 8 + hh % nhole; } else it = base8 + (h - n6 - n7);
        if (it < NEXP * 384 && ((it >= NEXP * 256) == down)) cvt_expert_item(wg, wu, wd, 1, ws + WS_WGU1, ws + WS_WD1, scr, it, lane); }
}
__device__ __forceinline__ void rms_row_to_bf16(const float* xrow, const float* gain, bf16* orow, bf16* xbrow, unsigned char* o8row, int lane) {
    const GAS f32x4* xr = (const GAS f32x4*)xrow + lane; const GAS f32x4* gr = (const GAS f32x4*)gain + lane;
    f32x4 v[4]; float s = 0.f;
#pragma unroll
    for (int j = 0; j < 4; ++j) { v[j] = xr[64 * j]; s += (v[j].x * v[j].x + v[j].y * v[j].y) + (v[j].z * v[j].z + v[j].w * v[j].w); }
    const float rs = rsqrtf(wave_sum(s) * (1.f / DM) + RMS_EPS);
    GAS v2u* o8 = (GAS v2u*)orow + lane; GAS v2u* x8 = (GAS v2u*)xbrow + lane;
#pragma unroll
    for (int j = 0; j < 4; ++j) { v2u xw; xw.x = pk2(v[j].x, v[j].y); xw.y = pk2(v[j].z, v[j].w); x8[64 * j] = xw; }
#pragma unroll
    for (int j = 0; j < 4; ++j) { const f32x4 g = gr[64 * j]; const f32x4 hv = {v[j].x * rs * g.x, v[j].y * rs * g.y, v[j].z * rs * g.z, v[j].w * rs * g.w}; v2u w; w.x = pk2(hv.x, hv.y); w.y = pk2(hv.z, hv.w); o8[64 * j] = w;
        ((GAS unsigned*)o8row)[lane + 64 * j] = pg8::pk4_fp8(pg8::X8_MUL * hv.x, pg8::X8_MUL * hv.y, pg8::X8_MUL * hv.z, pg8::X8_MUL * hv.w); }
}

__device__ __forceinline__ void rms_rows4(const float* x, bf16* xb, unsigned char* x8p, float* rsout, int m0, int step, int lane) {
    f32x4 v[4][4]; float s[4];
#pragma unroll
    for (int u = 0; u < 4; ++u) { const int m = m0 + u * step; s[u] = 0.f; if (m < NTOK) { const GAS f32x4* xr = (const GAS f32x4*)(x + (size_t)m * DM) + lane;
#pragma unroll
        for (int j = 0; j < 4; ++j) v[u][j] = xr[64 * j]; } }
#pragma unroll
    for (int u = 0; u < 4; ++u) { const int m = m0 + u * step; if (m < NTOK) {
#pragma unroll
        for (int j = 0; j < 4; ++j) s[u] += (v[u][j].x * v[u][j].x + v[u][j].y * v[u][j].y) + (v[u][j].z * v[u][j].z + v[u][j].w * v[u][j].w);
        const float rs = rsqrtf(wave_sum(s[u]) * (1.f / DM) + RMS_EPS);
        if (lane == 0) rsout[m] = rs;
        GAS v2u* x8 = (GAS v2u*)(xb + (size_t)m * DM) + lane; GAS unsigned* q8 = (GAS unsigned*)(x8p + (size_t)m * DM) + lane;
#pragma unroll
        for (int j = 0; j < 4; ++j) { const f32x4 xv = v[u][j]; v2u xw; xw.x = pk2(xv.x, xv.y); xw.y = pk2(xv.z, xv.w); x8[64 * j] = xw;
            q8[64 * j] = pg8::pk4_fp8(pg8::X8_MUL * xv.x, pg8::X8_MUL * xv.y, pg8::X8_MUL * xv.z, pg8::X8_MUL * xv.w); } } }
}

constexpr int RA_PITCH = 2064, RA_HI = 0, RA_LO = 32 * RA_PITCH, RA_RED = 2 * 32 * RA_PITCH, RT_REC = RA_RED + 8192, RT_CNT = RT_REC + 2048, RT_BASE = RT_CNT + 128;
typedef short rbf16x8 __attribute__((ext_vector_type(8)));
typedef float rf32x16 __attribute__((ext_vector_type(16)));
template <int CTRL> __device__ __forceinline__ float dppf(float v) { return __uint_as_float((unsigned)__builtin_amdgcn_update_dpp(0, (int)__float_as_uint(v), CTRL, 0xf, 0xf, false)); }
__device__ __forceinline__ float rlane(float v, int l) { return __uint_as_float((unsigned)__builtin_amdgcn_readlane((int)__float_as_uint(v), l)); }
__device__ __forceinline__ void router_phase(LAS unsigned char* lds, const bf16* x, const float* gain, const bf16* rtw, const float* b_rg, const float* b_re,
                                             unsigned char* h2, unsigned* gcnt, unsigned* tokinfo, unsigned* elist, int blk, int G, int tid, int lane, int wave) {
    LAS float* part = (LAS float*)(lds + RA_HI);
    LAS unsigned* rec = (LAS unsigned*)(lds + RT_REC); LAS unsigned* cntL = (LAS unsigned*)(lds + RT_CNT); LAS unsigned* baseL = (LAS unsigned*)(lds + RT_BASE);
    const int r32 = lane & 31, hi = lane >> 5;
    rbf16x8 bh[8][2], bl[8][2];
#pragma unroll
    for (int ks = 0; ks < 8; ++ks)
#pragma unroll
        for (int cb = 0; cb < 2; ++cb) { const GAS rbf16x8* p = (const GAS rbf16x8*)(rtw + (size_t)(cb * 32 + r32) * DM + wave * 128 + ks * 16 + hi * 8); bh[ks][cb] = p[0]; bl[ks][cb] = p[64 * DM / 8]; }
    float bias = 0.f; if (lane < 4) bias = b_rg[lane]; else if (lane < 36) bias = b_re[lane - 4];
    f32x4 gq[4];
#pragma unroll
    for (int j = 0; j < 4; ++j) gq[j] = ((const GAS f32x4*)gain)[lane + 64 * j];
    for (int chunk = blk; chunk < NTOK / 128; chunk += G) {
        if (tid < 32) cntL[tid] = 0u;
        __syncthreads();
        const int tok0 = chunk * 128;
#pragma unroll 1
        for (int sub = 0; sub < 4; ++sub) {
            const int t0 = tok0 + sub * 32 + wave * 4;
#pragma unroll
            for (int r = 0; r < 4; ++r) {
                const GAS v2u* xr = (const GAS v2u*)(x + (size_t)(t0 + r) * DM) + lane; f32x4 v[4]; float s = 0.f;
#pragma unroll
                for (int j = 0; j < 4; ++j) { const v2u xw = xr[64 * j]; v[j] = (f32x4){bflo(xw.x), bfhi(xw.x), bflo(xw.y), bfhi(xw.y)}; s += (v[j].x * v[j].x + v[j].y * v[j].y) + (v[j].z * v[j].z + v[j].w * v[j].w); }
                const float rs = rsqrtf(wave_sum(s) * (1.f / DM) + RMS_EPS);
                GAS unsigned* o4 = (GAS unsigned*)(h2 + (size_t)(t0 + r) * DM) + lane;
                LAS unsigned char* arow = lds + (wave * 4 + r) * RA_PITCH + lane * 8;
#pragma unroll
                for (int j = 0; j < 4; ++j) { const f32x4 xn = v[j] * rs * gq[j];
                    const unsigned h0 = f2bf(xn.x), h1 = f2bf(xn.y), h2_ = f2bf(xn.z), h3 = f2bf(xn.w);
                    v2u wh; wh.x = h0 | (h1 << 16); wh.y = h2_ | (h3 << 16); o4[64 * j] = pg8::pk4_fp8(pg8::X8_MUL * xn.x, pg8::X8_MUL * xn.y, pg8::X8_MUL * xn.z, pg8::X8_MUL * xn.w);
                    v2u wl; wl.x = pk2(xn.x - __uint_as_float(h0 << 16), xn.y - __uint_as_float(h1 << 16)); wl.y = pk2(xn.z - __uint_as_float(h2_ << 16), xn.w - __uint_as_float(h3 << 16));
                    *(LAS v2u*)(arow + RA_HI + j * 512) = wh; *(LAS v2u*)(arow + RA_LO + j * 512) = wl; }
            }
            __syncthreads();
            rf32x16 acc0 = {}, acc1 = {};
            { const LAS unsigned char* ap = lds + r32 * RA_PITCH + (wave * 128 + hi * 8) * 2;
#pragma unroll
              for (int ks = 0; ks < 8; ++ks) { const rbf16x8 ah = *(const LAS rbf16x8*)(ap + RA_HI + ks * 32), al = *(const LAS rbf16x8*)(ap + RA_LO + ks * 32);
                acc0 = __builtin_amdgcn_mfma_f32_32x32x16_bf16(ah, bh[ks][0], acc0, 0, 0, 0); acc1 = __builtin_amdgcn_mfma_f32_32x32x16_bf16(ah, bh[ks][1], acc1, 0, 0, 0);
                acc0 = __builtin_amdgcn_mfma_f32_32x32x16_bf16(al, bh[ks][0], acc0, 0, 0, 0); acc1 = __builtin_amdgcn_mfma_f32_32x32x16_bf16(al, bh[ks][1], acc1, 0, 0, 0);
                acc0 = __builtin_amdgcn_mfma_f32_32x32x16_bf16(ah, bl[ks][0], acc0, 0, 0, 0); acc1 = __builtin_amdgcn_mfma_f32_32x32x16_bf16(ah, bl[ks][1], acc1, 0, 0, 0); } }
            __syncthreads();
#pragma unroll
            for (int rg = 0; rg < 16; ++rg) { const int row = (rg & 3) + 8 * (rg >> 2) + 4 * hi;
                part[(wave * 32 + row) * 40 + r32] = acc0[rg];
                if (r32 < 4) part[(wave * 32 + row) * 40 + 32 + r32] = acc1[rg]; }
            __syncthreads();
#pragma unroll
            for (int r = 0; r < 4; ++r) {
                float lsum = 0.f;
                if (lane < 36) {
#pragma unroll
                    for (int w = 0; w < 8; ++w) lsum += part[(w * 32 + wave * 4 + r) * 40 + lane]; }
                const float lv = lsum + bias;
                const float g0 = rlane(lv, 0), g1 = rlane(lv, 1), g2 = rlane(lv, 2), g3 = rlane(lv, 3);
                int gs = 0; float gm = g0; if (g1 > gm) { gm = g1; gs = 1; } if (g2 > gm) { gm = g2; gs = 2; } if (g3 > gm) { gm = g3; gs = 3; }
                const float gw = 1.0f / (__expf(g0 - gm) + __expf(g1 - gm) + __expf(g2 - gm) + __expf(g3 - gm));
                gs = __builtin_amdgcn_readfirstlane(gs);
                float ev[8];
#pragma unroll
                for (int i = 0; i < 8; ++i) ev[i] = rlane(lv, 4 + gs * 8 + i);
                int i1 = 0; float v1 = ev[0];
#pragma unroll
                for (int i = 1; i < 8; ++i) if (ev[i] > v1) { v1 = ev[i]; i1 = i; }
                int i2 = -1; float v2 = -3.0e38f;
#pragma unroll
                for (int i = 0; i < 8; ++i) if (i != i1 && ev[i] > v2) { v2 = ev[i]; i2 = i; }
                const float e21 = __expf(v2 - v1), inv = 1.0f / (1.0f + e21);
                const float wa = gw * inv, wb = gw * e21 * inv;
                if (lane == 0) {
                    const int e1 = gs * 8 + i1, e2 = gs * 8 + i2;
                    const unsigned p1 = __hip_atomic_fetch_add(&cntL[e1], 1u, __ATOMIC_RELAXED, __HIP_MEMORY_SCOPE_WORKGROUP), p2 = __hip_atomic_fetch_add(&cntL[e2], 1u, __ATOMIC_RELAXED, __HIP_MEMORY_SCOPE_WORKGROUP);
                    LAS unsigned* rp = rec + (t0 + r - tok0) * 4;
                    rp[0] = (unsigned)e1 | ((unsigned)e2 << 8); rp[1] = p1 | (p2 << 16); rp[2] = __float_as_uint(wa); rp[3] = __float_as_uint(wb);
                }
            }
            __syncthreads();
        }
        if (tid < 32) baseL[tid] = __hip_atomic_fetch_add(gcnt + tid, cntL[tid], RLX_AGENT);
        __syncthreads();
        if (tid < 128) {
            const unsigned ee = rec[tid * 4 + 0], pp = rec[tid * 4 + 1]; const unsigned e1 = ee & 255u, e2 = ee >> 8;
            v4u a; a.x = e1; a.y = baseL[e1] + (pp & 0xffffu); a.z = e2; a.w = baseL[e2] + (pp >> 16);
            v4u b; b.x = rec[tid * 4 + 2]; b.y = rec[tid * 4 + 3]; b.z = 0u; b.w = 0u;
            GAS v4u* ti = (GAS v4u*)(tokinfo + (size_t)(tok0 + tid) * 8); ti[0] = a; ti[1] = b;
            elist[(size_t)e1 * NTOK + a.y] = (unsigned)(tok0 + tid); elist[(size_t)e2 * NTOK + a.w] = (unsigned)(tok0 + tid);
        }
        __syncthreads();
    }
}
__device__ __forceinline__ void cvt_router_weights(const float* w_rg, const float* w_re, bf16* rtw, int gtid, int nthr) {
    for (int idx = gtid; idx < DEPTH * 64 * DM; idx += nthr) { const int l = idx >> 16, col = (idx >> 10) & 63, k = idx & 1023;
        const float v = col < 4 ? w_rg[((size_t)l * DM + k) * 4 + col] : (col < 36 ? w_re[((size_t)l * DM + k) * 32 + col - 4] : 0.f);
        const unsigned hb = f2bf(v); const float lo = v - __uint_as_float(hb << 16);
        rtw[(size_t)l * 2 * 64 * DM + (size_t)col * DM + k] = (bf16)hb; rtw[(size_t)l * 2 * 64 * DM + 64 * DM + (size_t)col * DM + k] = (bf16)f2bf(lo); }
}
__device__ __forceinline__ void moe_tables(volatile LAS unsigned* MISC, const unsigned* gcnt, int tid) {
    if (tid == 0) {
        unsigned ps = 0, T = 0;
        for (int e = 0; e < NEXP; ++e) { const unsigned cnt = __hip_atomic_load(gcnt + e, RLX_AGENT); const unsigned nt = (cnt + 255u) >> 8;
            MISC[MW_PAD + e] = ps; MISC[MW_CNT + e] = cnt; for (unsigned k = 0; k < nt && T < (unsigned)RMAX_TILES; ++k) MISC[MW_TILE + (T++)] = (unsigned)e; ps += nt * 256u; }
        MISC[MW_PAD + NEXP] = ps; MISC[MW_NT] = T;
    }
    __syncthreads();
}
__device__ __forceinline__ void moe_rowtab(volatile LAS unsigned* MISC, const unsigned* elist, int blk, int G, int tid) {
    const int nunits = (int)MISC[MW_NT] * 4;
    for (int ui = 0; ui < ROWTAB_UNITS; ++ui) { const int Lu = ui * G + blk; if (Lu >= nunits) break;
        const int pm = pg8::MoeOrder::unit_of(Lu, nunits) >> 2; const unsigned e = MISC[MW_TILE + pm];
        if (tid < 256) { const unsigned slot = (unsigned)(pm * 256 + tid) - MISC[MW_PAD + e]; MISC[MW_ROW + ui * 256 + tid] = slot < MISC[MW_CNT + e] ? elist[(size_t)e * NTOK + slot] : 0u; } }
    __syncthreads();
}
template <bool LAST> __device__ __forceinline__ void combine_phase(volatile LAS unsigned* MISC, const bf16* xin, bf16* xout, float* fout, const unsigned char* ys, const unsigned* tokinfo, const float* gain, float* rsout, unsigned char* hn8, int gw, int ngw, int lane) {
    f32x4 gq[4];
#pragma unroll
    for (int j = 0; j < 4; ++j) gq[j] = LAST ? ((const GAS f32x4*)gain)[lane + 64 * j] : (f32x4){0.f, 0.f, 0.f, 0.f};
    v4u ra[2], rb[2];
#pragma unroll
    for (int u = 0; u < 2; ++u) { const int tok = gw + u * ngw; ra[u] = (v4u){0u, 0u, 0u, 0u}; rb[u] = ra[u]; if (tok < NTOK) { const GAS v4u* ti = (const GAS v4u*)(tokinfo + (size_t)tok * 8); ra[u] = ti[0]; rb[u] = ti[1]; } }
    for (int tok0 = gw; tok0 < NTOK; tok0 += 2 * ngw) {
        f32x4 v[2][4]; unsigned p[2][4], q[2][4]; float w1[2], w2[2];
        v4u ca[2], cb[2];
#pragma unroll
        for (int u = 0; u < 2; ++u) { ca[u] = ra[u]; cb[u] = rb[u]; const int tokn = tok0 + (2 + u) * ngw; if (tokn < NTOK) { const GAS v4u* tn = (const GAS v4u*)(tokinfo + (size_t)tokn * 8); ra[u] = tn[0]; rb[u] = tn[1]; } }
#pragma unroll
        for (int u = 0; u < 2; ++u) { const int tok = tok0 + u * ngw; if (tok < NTOK) {
            const v4u a = ca[u], b = cb[u];
            const unsigned r1 = MISC[MW_PAD + a.x] + a.y, r2 = MISC[MW_PAD + a.z] + a.w; w1[u] = __uint_as_float(b.x) * (1.0f / pg8::YS8_MUL); w2[u] = __uint_as_float(b.y) * (1.0f / pg8::YS8_MUL);
            const GAS v2u* xi = (const GAS v2u*)(xin + (size_t)tok * DM) + lane;
            const GAS unsigned* y1 = (const GAS unsigned*)(ys + (size_t)r1 * DM) + lane; const GAS unsigned* y2 = (const GAS unsigned*)(ys + (size_t)r2 * DM) + lane;
#pragma unroll
            for (int j = 0; j < 4; ++j) { const v2u xw = xi[64 * j]; v[u][j] = (f32x4){bflo(xw.x), bfhi(xw.x), bflo(xw.y), bfhi(xw.y)}; p[u][j] = y1[64 * j]; q[u][j] = y2[64 * j]; } } }
#pragma unroll
        for (int u = 0; u < 2; ++u) { const int tok = tok0 + u * ngw; if (tok < NTOK) {
            float s = 0.f;
#pragma unroll
            for (int j = 0; j < 4; ++j) { f32x4& x = v[u][j]; const f32x4 pp = fp8x4_to_f32(p[u][j]), qq = fp8x4_to_f32(q[u][j]);
                x += pp * w1[u] + qq * w2[u];
                s += (x.x * x.x + x.y * x.y) + (x.z * x.z + x.w * x.w); }
            const float rs = rsqrtf(wave_sum(s) * (1.f / DM) + RMS_EPS);
            if (LAST) {
                GAS f32x4* xr = (GAS f32x4*)(fout + (size_t)tok * DM) + lane;
#pragma unroll
                for (int j = 0; j < 4; ++j) xr[64 * j] = v[u][j] * rs * gq[j];
            } else {
                GAS v2u* x8 = (GAS v2u*)(xout + (size_t)tok * DM) + lane; if (lane == 0) rsout[tok] = rs;
#pragma unroll
                for (int j = 0; j < 4; ++j) { const f32x4 x = v[u][j]; v2u xw; xw.x = pk2(x.x, x.y); xw.y = pk2(x.z, x.w); x8[64 * j] = xw;
                    ((GAS unsigned*)(hn8 + (size_t)tok * DM))[lane + 64 * j] = pg8::pk4_fp8(pg8::X8_MUL * x.x, pg8::X8_MUL * x.y, pg8::X8_MUL * x.z, pg8::X8_MUL * x.w); }
            } } }
    }
}

struct Args { const float* in[19]; float* out; unsigned char* ws; };
__global__ void __launch_bounds__(NWAVES * 64, 2) fwd_kernel(Args args) {
    extern __shared__ __attribute__((aligned(16))) unsigned char lds[];
    LAS unsigned char* L = (LAS unsigned char*)lds;
    volatile LAS unsigned* MISC = (volatile LAS unsigned*)(L + LDS_MISC);
    int tid = threadIdx.x, lane = tid & 63, wave = __builtin_amdgcn_readfirstlane(tid >> 6);
    const int G = gridDim.x, blk = blockIdx.x;
    const int vcu = (G % 8 == 0) ? (blk % 8) * (G / 8) + blk / 8 : blk;
    int gw = vcu * NWAVES + wave; const int ngw = G * NWAVES;
#define RELANE() do { tid = threadIdx.x; asm volatile("" : "+v"(tid)); lane = tid & 63; wave = __builtin_amdgcn_readfirstlane(tid >> 6); gw = vcu * NWAVES + wave; scr = (LAS float*)(L + wave * TR_SCR); } while (0)
    unsigned char* ws = args.ws;
    unsigned* ctl = (unsigned*)(ws + WS_CTL);
    for (int u = tid; u < (LDS_BYTES - LDS_MISC) / 4; u += NWAVES * 64) MISC[u] = 0u;
    __syncthreads();
    XcdBarrier bar = xcd_barrier_post(ctl + CW_BAR, MISC);
#define GRID_BAR() do { unsigned x_ = bar.x; asm volatile("" : "+s"(x_)); bar.x = x_; xcd_barrier(bar); } while (0)
    const float* x_in = args.in[0];
    bf16* XB0 = (bf16*)args.out; bf16* XB1 = (bf16*)(ws + WS_O);
    bf16* Hb = (bf16*)(ws + WS_H); bf16* QKV = (bf16*)(ws + WS_QKV); bf16* GATES = (bf16*)(ws + WS_GATES); bf16* OB = (bf16*)(ws + WS_O);
    unsigned char* YS = (unsigned char*)QKV; bf16* HID = GATES; bf16* MERGED = Hb;
    unsigned* tokinfo = (unsigned*)(ws + WS_TOK); unsigned* elist = (unsigned*)(ws + WS_LIST);
    LAS float* scr = (LAS float*)(L + wave * TR_SCR);
    RELANE();

    for (int rep_ = 0; rep_ < REPS(0); ++rep_) {
    if (PH(0)) {
#pragma unroll 1
    for (int pass_ = 0; pass_ < 2; ++pass_) {
        if ((pass_ ^ (wave & 1)) == 0) {
    cvt_small_weights(args.in[1], args.in[9], args.in[5], args.in[6], args.in[7], ws, scr, gw, ngw, lane);
    cvt_expert_weights(args.in[15], args.in[16], args.in[17], 0, ws, scr, gw, ngw, lane, FILL_P1 * (G / 2) * 8);
    cvt_router_weights(args.in[11], args.in[13], (bf16*)(ws + WS_RTW), vcu * (NWAVES * 64) + tid, G * NWAVES * 64);
        } else {
    for (int m = gw; m < NTOK; m += 4 * ngw) rms_rows4(x_in, XB0, ws + WS_H8, (float*)(ws + WS_RS), m, ngw, lane);
        } }
    }
    GRID_BAR();
    }

#pragma unroll 1
    for (int l = 0; l < DEPTH; ++l) {
        for (int rep_ = 0; rep_ < REPS(1); ++rep_) {
        if (PH(1)) {
            if constexpr (P1_NB16 > 0) { pg8::Gemm g{XB0, (const bf16*)(ws + WS_WIN) + (size_t)l * INC * DM, NTOK, INC, DM}; pg8::ColWindowOrder S; S.init(NTOK, P1_NB16 * 256, P1_B16_TILES, G, blk);
              pg8::EpiInProj E{QKV, GATES, (const float*)(ws + WS_RS)};
              pg8::gemm_phase<pg8::EpiInProj, pg8::ColWindowOrder, true, true>(L, g, S, E); }
            { pg8::Gemm g{(const bf16*)(ws + WS_H8), (const bf16*)(ws + WS_WG8 + (size_t)l * INC * DM), NTOK, INC, DM / 2}; pg8::LateOrder S; S.init(NTOK, P1_NF8 * 256, P1_F8_TILES, G, blk);
              pg8::EpiInProj8 E{QKV, (unsigned char*)GATES, (const float*)(ws + WS_RS)};
              pg8::gemm_phase<pg8::EpiInProj8, pg8::LateOrder, true, true>(L, g, S, E); }
            if (FILL_P1 > 0 && ((P1_NB16 & 1) ? blk < G / 2 : blk >= G / 2)) { asm volatile("s_waitcnt vmcnt(0) lgkmcnt(0)" ::: "memory"); __syncthreads(); RELANE(); cvt_fill_slots(args.in[15], args.in[16], args.in[17], ws, scr, 0, (G / 2) * 8, (blk % (G / 2)) * 8 + wave, FILL_P1, lane, l); }
        }
        GRID_BAR();
        }
        {
            const float lambda_init = 0.8f - 0.6f * __expf(-0.3f * (float)l);
            att::DiffParams dp{args.in[2] + l * 256, args.in[3] + l * 128, lambda_init};
            for (int rep_ = 0; rep_ < REPS(2); ++rep_) { if (PH(2))
            { int hp = -1; for (int u = vcu; u < NBATCH * 4 * 16; u += G) { const int bh = u >> 4, qb = u & 15; att::attn_unit<true>((char*)lds, QKV, OB, bh >> 2, bh & 3, qb * 128, args.in[8], nullptr, dp, (bh & 3) != hp); hp = bh & 3; } }
            if (rep_ + 1 < REPS(2)) GRID_BAR(); }
            for (int rep_ = 0; rep_ < REPS(10); ++rep_) { if (PH(2))
            { int hp = -1; for (int u = vcu; u < NBATCH * 2 * 16; u += G) { const int bh = u >> 4, qb = u & 15; att::attn_unit_win2((char*)lds, QKV, OB, bh >> 1, bh & 1, qb * 128, args.in[8], args.in[4] + l * 8, (bh & 1) != hp); hp = bh & 1; } }
            if (rep_ + 1 < REPS(10)) GRID_BAR(); }
        }
        GRID_BAR();
        for (int rep_ = 0; rep_ < REPS(3); ++rep_) {
        if (PH(3)) {
            pg8::Gemm g{OB, (const bf16*)(ws + WS_PT + (size_t)l * DM * DM), NTOK, DM, DM / 2}; pg8::StaticOrder S; S.init(NTOK, DM, G, blk);
            pg8::EpiMergeF8 E{(const unsigned char*)GATES, (unsigned char*)MERGED};
            pg8::gemm_phase<pg8::EpiMergeF8, pg8::StaticOrder, true, true>(L, g, S, E);
        }
        GRID_BAR();
        }
        for (int rep_ = 0; rep_ < (l == 0 ? REPS(4) : 1); ++rep_) {
        if (PH(4)) {
            pg8::Gemm g{MERGED, (const bf16*)(ws + WS_WO + (size_t)l * DM * DM), NTOK, DM, DM / 2}; pg8::StaticOrder S; S.init(NTOK, DM, G, blk);
            pg8::EpiResid8 E{XB0, l + 1 < DEPTH ? XB0 : XB1};
            pg8::gemm_phase<pg8::EpiResid8, pg8::StaticOrder, true, true>(L, g, S, E);
        }
        GRID_BAR();
        }
        RELANE();
        if (PH(5)) router_phase(L, l + 1 < DEPTH ? XB0 : XB1, args.in[10] + l * DM, (const bf16*)(ws + WS_RTW) + (size_t)l * 2 * 64 * DM, args.in[12] + l * 4, args.in[14] + l * 32,
                     (unsigned char*)Hb, ctl + CW_CNT + 64 * l, tokinfo, elist, blk, G, tid, lane, wave);
        GRID_BAR();
        RELANE();
        moe_tables(MISC, ctl + CW_CNT + 64 * l, tid);
        moe_rowtab(MISC, elist, blk, G, tid);
        for (int rep_ = 0; rep_ < REPS(7); ++rep_) {
        if (PH(7)) {
            const int ntile = __builtin_amdgcn_readfirstlane((int)MISC[MW_NT]);
            pg8::Gemm g{Hb, (const bf16*)(ws + (l == 0 ? WS_WGU : WS_WGU1)), ntile * 256, 1024, DM / 2}; pg8::MoeOrder S{ntile * 4, G, blk, (const LAS int*)(L + LDS_MISC) + MW_TILE, (const LAS int*)(L + LDS_MISC) + MW_ROW};
            pg8::EpiSwiGlu8 E{(unsigned char*)HID};
            pg8::gemm_phase_gather<pg8::EpiSwiGlu8, pg8::MoeOrder, true, true>(L, g, S, E);
            if (FILL_P6 > 0 && l == 0) { const int nun = ntile * 4, my = blk < nun ? (nun - 1 - blk) / G + 1 : 0; if (my < (nun + G - 1) / G) { asm volatile("s_waitcnt vmcnt(0) lgkmcnt(0)" ::: "memory"); __syncthreads(); RELANE(); cvt_fill_slots(args.in[15], args.in[16], args.in[17], ws, scr, FILL_P1 * (G / 2) * 8, G * 8, (blk - nun % G) * 8 + wave, FILL_P6, lane); } }
            else if (FILL_P6 > 0 && l == 1) { const int nun = ntile * 4, r = nun % G; if (r == 0 || blk >= r) { asm volatile("s_waitcnt vmcnt(0) lgkmcnt(0)" ::: "memory"); __syncthreads(); RELANE();
                const int nun0 = __builtin_amdgcn_readfirstlane((int)MISC[MW_NT + 1]) * 4; cvt_leftover(args.in[15], args.in[16], args.in[17], ws, scr, G, nun0, (r == 0 ? blk : blk - r) * 8 + wave, (r == 0 ? G : G - r) * 8, lane, true); } }
        }
        GRID_BAR();
        }
        for (int rep_ = 0; rep_ < REPS(8); ++rep_) {
        if (PH(8)) {
            const int ntile = __builtin_amdgcn_readfirstlane((int)MISC[MW_NT]);
            pg8::Gemm g{HID, (const bf16*)(ws + (l == 0 ? WS_WD : WS_WD1)), ntile * 256, 1024, FH / 2}; pg8::MoeOrder S{ntile * 4, G, blk, (const LAS int*)(L + LDS_MISC) + MW_TILE, nullptr};
            pg8::EpiDown8 E{YS};
            pg8::gemm_phase<pg8::EpiDown8, pg8::MoeOrder, true, true>(L, g, S, E);
            if (FILL_P7 > 0 && l == 0) { const int nun = ntile * 4, my = blk < nun ? (nun - 1 - blk) / G + 1 : 0; if (my < (nun + G - 1) / G) { asm volatile("s_waitcnt vmcnt(0) lgkmcnt(0)" ::: "memory"); __syncthreads(); RELANE(); cvt_fill_slots(args.in[15], args.in[16], args.in[17], ws, scr, FILL_P1 * (G / 2) * 8 + FILL_P6 * G * 8, G * 8, (blk - nun % G) * 8 + wave, FILL_P7, lane); } }
        }
        GRID_BAR();
        }
        RELANE();
        if (!PH(9)) {} else if (l + 1 < DEPTH) {
            combine_phase<false>(MISC, XB0, XB0, nullptr, YS, tokinfo, nullptr, (float*)(ws + WS_RS), ws + WS_H8, gw, ngw, lane);
{ const int ntile = __builtin_amdgcn_readfirstlane((int)MISC[MW_NT]); cvt_leftover(args.in[15], args.in[16], args.in[17], ws, scr, G, ntile * 4, gw, ngw, lane, false); if (tid == 0) MISC[MW_NT + 1] = (unsigned)ntile; }
            GRID_BAR();
        } else {
            combine_phase<true>(MISC, XB1, nullptr, args.out, YS, tokinfo, args.in[18], nullptr, nullptr, gw, ngw, lane);
        }
    }
}

extern "C" void kernel_launch(void* const* d_in, const int* in_sizes, int n_in, void* d_out, int out_size, void* d_ws, size_t ws_size, hipStream_t stream) {
    static int grid = 0;
    if (grid == 0) {
        if (n_in != 19 || in_sizes[0] != NTOK * DM || out_size != NTOK * DM || ws_size < WS_END) {
            fprintf(stderr, "kernel_launch: built for 19 inputs, x/out of %d floats, >= %zu bytes of workspace; got n_in %d, in0 %d, out %d, ws %zu; nothing launched\n", NTOK * DM, (size_t)WS_END, n_in, n_in > 0 ? in_sizes[0] : -1, out_size, ws_size);
            grid = -1; return; }
        int dev = 0, cus = 0, per_cu = 0;
        if (hipGetDevice(&dev) != hipSuccess || hipDeviceGetAttribute(&cus, hipDeviceAttributeMultiprocessorCount, dev) != hipSuccess) { fprintf(stderr, "kernel_launch: device query failed\n"); grid = -1; return; }
        if (hipFuncSetAttribute((const void*)fwd_kernel, hipFuncAttributeMaxDynamicSharedMemorySize, LDS_BYTES) != hipSuccess) { fprintf(stderr, "kernel_launch: hipFuncSetAttribute failed\n"); grid = -1; return; }
        if (hipOccupancyMaxActiveBlocksPerMultiprocessor(&per_cu, (const void*)fwd_kernel, NWAVES * 64, LDS_BYTES) != hipSuccess || per_cu < 1)
            fprintf(stderr, "kernel_launch: note: occupancy query reports %d workgroups per CU\n", per_cu);
        (void)hipGetLastError();
        grid = cus;
    }
    if (grid < 0) return;
    if (hipMemsetAsync((char*)d_ws + WS_CTL, 0, CTL_ZERO_BYTES, stream) != hipSuccess) { fprintf(stderr, "kernel_launch: hipMemsetAsync failed\n"); return; }
    Args a{};
    for (int i = 0; i < 19; ++i) a.in[i] = (const float*)d_in[i];
    a.out = (float*)d_out; a.ws = (unsigned char*)d_ws;
    hipLaunchKernelGGL(fwd_kernel, dim3(grid), dim3(NWAVES * 64), LDS_BYTES, stream, a);
    const hipError_t le = hipPeekAtLastError();
    if (le != hipSuccess) fprintf(stderr, "kernel_launch: launch failed: %s\n", hipGetErrorName(le));
}
```
